# Optimizing an MI355X kernel written in HIP

```python
import jax, jax.numpy as jnp
from jax import lax
import numpy as np

D_MODEL = 4096
BATCH = 4
SEQ = 4096
DEPTH = 1
DEC_BATCH = 1
DEC_SEQ = 8192
PAST_LEN = 128

HEAD_DIM = 128
N_Q_HEADS = 16
N_KV_HEADS = 4
GQA_GROUP = N_Q_HEADS // N_KV_HEADS
ATTN_WIDTH = N_Q_HEADS * HEAD_DIM
KV_WIDTH = N_KV_HEADS * HEAD_DIM
Q_BLOCK = 128
ROPE_THETA = 10000.0
AXIS_DIM = HEAD_DIM // 2
GRID_W = 64
D_RNN = D_MODEL // 2
LRU_BLOCKS = 16
LRU_BLOCK_W = D_RNN // LRU_BLOCKS
LRU_C = 8.0
CONV_W = 4
CONV_PAD_LO = 1
D_FF = 4 * D_MODEL
NORM_EPS = 1e-6
IN_WIDTH = ATTN_WIDTH + 2 * KV_WIDTH + 2 * D_RNN + 2 * D_MODEL

kernel_name = "hybrid_gated_rglru_axial_gqa_encoder"


def _rmsnorm(x, g):
    xf = x.astype(jnp.float32)
    y = xf * lax.rsqrt(jnp.mean(xf * xf, axis=-1, keepdims=True) + NORM_EPS)
    return (y * g.astype(jnp.float32)).astype(x.dtype)


def _axial_rope_tables(seq_len):
    n_rows = seq_len // GRID_W
    row = jnp.repeat(jnp.arange(n_rows), GRID_W).astype(jnp.float32)
    col = jnp.tile(jnp.arange(GRID_W), n_rows).astype(jnp.float32)
    inv = ROPE_THETA ** (-jnp.arange(0, AXIS_DIM, 2, dtype=jnp.float32) / AXIS_DIM)
    ang = jnp.concatenate([row[:, None] * inv, col[:, None] * inv], axis=-1)
    return jnp.cos(ang), jnp.sin(ang)


def _apply_rope(x, cos, sin):
    B, S, H, _ = x.shape
    xf = x.astype(jnp.float32).reshape(B, S, H, HEAD_DIM // 2, 2)
    c = cos[None, :, None, :]
    s = sin[None, :, None, :]
    x1, x2 = xf[..., 0], xf[..., 1]
    out = jnp.stack([x1 * c - x2 * s, x1 * s + x2 * c], axis=-1)
    return out.reshape(B, S, H, HEAD_DIM).astype(x.dtype)


def _block_attention(q, k, v):
    B, S = q.shape[:2]
    nblk = S // Q_BLOCK
    qb = q.reshape(B, nblk, Q_BLOCK, N_KV_HEADS, GQA_GROUP, HEAD_DIM).transpose(1, 0, 3, 4, 2, 5)
    scale = HEAD_DIM ** -0.5

    def one_block(qblk):
        s = jnp.einsum('bkgqd,bskd->bkgqs', qblk, k).astype(jnp.float32) * scale
        p = jax.nn.softmax(s, axis=-1).astype(v.dtype)
        return jnp.einsum('bkgqs,bskd->bkgqd', p, v)

    o = lax.map(one_block, qb)
    return o.transpose(1, 0, 4, 2, 3, 5).reshape(B, S, ATTN_WIDTH)


def _centred_dwconv(x, w, b):
    S = x.shape[1]
    xp = jnp.pad(x, ((0, 0), (CONV_PAD_LO, CONV_W - 1 - CONV_PAD_LO), (0, 0)))
    out = b
    for j in range(CONV_W):
        out = out + w[j] * xp[:, j:j + S]
    return out


def _lru_combine(left, right):
    a1, b1 = left
    a2, b2 = right
    return a1 * a2, a2 * b1 + b2


def _bidir_rg_lru(xc, w_a, b_a, w_i, b_i, lam):
    B, S, _ = xc.shape
    xf = xc.astype(jnp.float32)
    xb = xf.reshape(B, S, LRU_BLOCKS, LRU_BLOCK_W)
    r = jax.nn.sigmoid(jnp.einsum('bsnc,zncm->zbsnm', xb, w_a.astype(jnp.float32)).reshape(2, B, S, D_RNN)
                       + b_a.astype(jnp.float32)[:, None, None, :])
    i = jax.nn.sigmoid(jnp.einsum('bsnc,zncm->zbsnm', xb, w_i.astype(jnp.float32)).reshape(2, B, S, D_RNN)
                       + b_i.astype(jnp.float32)[:, None, None, :])
    log_a = -LRU_C * r * jax.nn.softplus(-lam.astype(jnp.float32))[:, None, None, :]
    a = jnp.exp(log_a)
    u = jnp.sqrt(-jnp.expm1(2.0 * log_a)) * (i * xf[None])
    _, h_fwd = lax.associative_scan(_lru_combine, (a[0], u[0]), axis=1)
    _, h_bwd = lax.associative_scan(_lru_combine, (a[1], u[1]), axis=1, reverse=True)
    return (h_fwd + h_bwd).astype(xc.dtype)


def _encoder_layer(x, norm_mix, w_in, q_norm, k_norm, conv_w, conv_b, lru_w_a, lru_b_a,
                   lru_w_i, lru_b_i, lru_lambda, w_attn_out, w_rnn_out, b_gate, w_out,
                   norm_mlp, w_up, w_down):
    B, S, _ = x.shape
    h = _rmsnorm(x, norm_mix)
    z = h @ w_in
    o1 = ATTN_WIDTH
    o2 = o1 + KV_WIDTH
    o3 = o2 + KV_WIDTH
    o4 = o3 + D_RNN
    o5 = o4 + D_RNN
    q, k, v, xr, yr, gl = jnp.split(z, [o1, o2, o3, o4, o5], axis=-1)

    cos, sin = _axial_rope_tables(S)
    q = _apply_rope(_rmsnorm(q.reshape(B, S, N_Q_HEADS, HEAD_DIM), q_norm), cos, sin)
    k = _apply_rope(_rmsnorm(k.reshape(B, S, N_KV_HEADS, HEAD_DIM), k_norm), cos, sin)
    v = v.reshape(B, S, N_KV_HEADS, HEAD_DIM)
    attn_branch = _block_attention(q, k, v) @ w_attn_out

    xc = _centred_dwconv(xr, conv_w, conv_b)
    rec = _bidir_rg_lru(xc, lru_w_a, lru_b_a, lru_w_i, lru_b_i, lru_lambda) * jax.nn.gelu(yr)
    rnn_branch = rec @ w_rnn_out

    gates = jax.nn.sigmoid(gl.reshape(B, S, 2, D_MODEL) + b_gate)
    merged = gates[:, :, 0] * attn_branch + gates[:, :, 1] * rnn_branch
    x = x + merged @ w_out

    hm = _rmsnorm(x, norm_mlp)
    x = x + jnp.square(jax.nn.relu(hm @ w_up)) @ w_down
    return x


def _trunk(x, norm_mix, w_in, q_norm, k_norm, conv_w, conv_b, lru_w_a, lru_b_a, lru_w_i,
           lru_b_i, lru_lambda, w_attn_out, w_rnn_out, b_gate, w_out, norm_mlp, w_up,
           w_down, norm_final):
    for l in range(DEPTH):
        x = _encoder_layer(x, norm_mix[l], w_in[l], q_norm[l], k_norm[l], conv_w[l], conv_b[l],
                           lru_w_a[l], lru_b_a[l], lru_w_i[l], lru_b_i[l], lru_lambda[l],
                           w_attn_out[l], w_rnn_out[l], b_gate[l], w_out[l], norm_mlp[l],
                           w_up[l], w_down[l])
    return _rmsnorm(x, norm_final)


def setup_inputs(seed: int = 0) -> dict:
    key = jax.random.key(seed)
    ks = jax.random.split(key, 24)
    f32 = jnp.float32

    def nrm(k, shape, fan_in):
        return jax.random.normal(k, shape, f32) * (fan_in ** -0.5)

    def gain(k, shape):
        return 1.0 + 0.02 * jax.random.normal(k, shape, f32)

    def small(k, shape):
        return 0.01 * jax.random.normal(k, shape, f32)

    u = jax.random.uniform(ks[13], (DEPTH, 2, D_RNN), f32, minval=0.9, maxval=0.999)
    a0 = u ** (1.0 / LRU_C)
    lru_lambda = jnp.log(a0) - jnp.log1p(-a0)
    return {
        "x_prompt": jax.random.normal(ks[0], (BATCH, SEQ, D_MODEL), f32),
        "x_sample": jax.random.normal(ks[1], (DEC_BATCH, DEC_SEQ, D_MODEL), f32),
        "norm_mix": gain(ks[2], (DEPTH, D_MODEL)),
        "w_in": nrm(ks[3], (DEPTH, D_MODEL, IN_WIDTH), D_MODEL),
        "q_norm": gain(ks[4], (DEPTH, HEAD_DIM)),
        "k_norm": gain(ks[5], (DEPTH, HEAD_DIM)),
        "conv_w": nrm(ks[6], (DEPTH, CONV_W, D_RNN), CONV_W),
        "conv_b": small(ks[7], (DEPTH, D_RNN)),
        "lru_w_a": nrm(ks[8], (DEPTH, 2, LRU_BLOCKS, LRU_BLOCK_W, LRU_BLOCK_W), LRU_BLOCK_W),
        "lru_b_a": small(ks[9], (DEPTH, 2, D_RNN)),
        "lru_w_i": nrm(ks[10], (DEPTH, 2, LRU_BLOCKS, LRU_BLOCK_W, LRU_BLOCK_W), LRU_BLOCK_W),
        "lru_b_i": small(ks[11], (DEPTH, 2, D_RNN)),
        "lru_lambda": lru_lambda,
        "w_attn_out": nrm(ks[14], (DEPTH, ATTN_WIDTH, D_MODEL), ATTN_WIDTH),
        "w_rnn_out": nrm(ks[15], (DEPTH, D_RNN, D_MODEL), D_RNN),
        "b_gate": small(ks[16], (DEPTH, 2, D_MODEL)),
        "w_out": nrm(ks[17], (DEPTH, D_MODEL, D_MODEL), D_MODEL),
        "norm_mlp": gain(ks[18], (DEPTH, D_MODEL)),
        "w_up": nrm(ks[19], (DEPTH, D_MODEL, D_FF), D_MODEL),
        "w_down": nrm(ks[20], (DEPTH, D_FF, D_MODEL), D_FF),
        "norm_final": gain(ks[21], (D_MODEL,)),
    }


def reference(x_prompt, x_sample, norm_mix, w_in, q_norm, k_norm, conv_w, conv_b, lru_w_a,
              lru_b_a, lru_w_i, lru_b_i, lru_lambda, w_attn_out, w_rnn_out, b_gate, w_out,
              norm_mlp, w_up, w_down, norm_final):
    y_prompt = _trunk(x_prompt, norm_mix, w_in, q_norm, k_norm, conv_w, conv_b, lru_w_a, lru_b_a,
                      lru_w_i, lru_b_i, lru_lambda, w_attn_out, w_rnn_out, b_gate, w_out,
                      norm_mlp, w_up, w_down, norm_final)
    y_sample = _trunk(x_sample, norm_mix, w_in, q_norm, k_norm, conv_w, conv_b, lru_w_a, lru_b_a,
                      lru_w_i, lru_b_i, lru_lambda, w_attn_out, w_rnn_out, b_gate, w_out,
                      norm_mlp, w_up, w_down, norm_final)
    return (y_prompt, y_sample)
```

```cpp
#define MK_STAGE 9
#define MK_PER_PHASE 1
#include <hip/hip_runtime.h>
#include <hip/hip_bf16.h>
#include <cstdio>
#include <cstdint>
namespace pg8 {
#define PG8_LAS __attribute__((address_space(3)))
typedef unsigned short bf16_t;
typedef short bf16x8 __attribute__((ext_vector_type(8)));
typedef float f32x4 __attribute__((ext_vector_type(4)));
typedef unsigned u32x4 __attribute__((ext_vector_type(4)));
constexpr int BM = 256, BK = 64, HALF = 128, HTB = HALF * BK * 2  , STAGE_BYTES = 8 * HTB, NXCD = 8, WGM = 8;

__host__ __device__ __forceinline__ int lds_byte(int r, int c) { const int st = (r >> 4) * 2 + (c >> 5), rr = r & 15, cc = c & 31, ob = rr * 64 + cc * 2; return st * 1024 + (ob ^ (((ob >> 9) & 1) << 5)); }
__host__ __device__ __forceinline__ void stage_rc(int b, int& R, int& C) { const int st = b / 1024, sb = b % 1024, swz = sb ^ (((sb >> 9) & 1) << 5); R = (st >> 1) * 16 + swz / 64; C = (st & 1) * 32 + (swz % 64) / 2; }
__host__ __device__ __forceinline__ int perm32(int rho) { const int n = rho >> 4, i = rho & 15; return 8 * (i >> 2) + 4 * n + (i & 3); }

struct Unit { int pm, pn; };
struct Gemm { const bf16_t* A; const bf16_t* Bt; int M, N, K; };

struct StaticOrder {
    int nM, nN, nwg, G, c;
    __host__ __device__ void init(int M, int N, int G_, int c_) { nM = M / BM; nN = N / BM; nwg = nM * nN; G = G_; c = c_; }
    __host__ __device__ bool next(int i, Unit& u) const {
        const long L = (long)i * G + c; if (L >= nwg) return false;
        int wgid = (int)L; { const int q = nwg / NXCD, r = nwg % NXCD, xcd = wgid % NXCD, off = wgid / NXCD; wgid = (xcd < r ? xcd * (q + 1) : r * (q + 1) + (xcd - r) * q) + off; }
        const int nig = WGM * nN, gid = wgid / nig, fm = gid * WGM, gsz = (nM - fm) < WGM ? (nM - fm) : WGM;
        u.pm = fm + ((wgid % nig) % gsz); u.pn = (wgid % nig) / gsz; return true;
    }
    __device__ __forceinline__ void a_ready(const Unit&) const {}
    __device__ __forceinline__ void done(const Unit&) const {}
};

__device__ __forceinline__ unsigned cvt_pk_bf16(float lo, float hi) { unsigned r; asm volatile("v_cvt_pk_bf16_f32 %0, %1, %2" : "=v"(r) : "v"(lo), "v"(hi)); return r; }
typedef float f32x2 __attribute__((ext_vector_type(2)));
__device__ __forceinline__ f32x2 gelu_pk(f32x2 v) {
    const f32x2 av = __builtin_elementwise_abs(v), d = av * 0.2316418882f + 1.0f;
    f32x2 t; t.x = __builtin_amdgcn_rcpf(d.x); t.y = __builtin_amdgcn_rcpf(d.y);
    f32x2 q = t * 0.5307027145f + (-0.7265760135f); q = q * t + 0.7107068705f; q = q * t + (-0.142248368f); q = q * t + 0.127414796f; q = q * t;
    const f32x2 s = (v * v) * (-0.72134752044f);
    f32x2 e; e.x = __builtin_amdgcn_exp2f(s.x); e.y = __builtin_amdgcn_exp2f(s.y);
    const f32x2 m = v * (q * e), r = v - m;
    f32x2 o; o.x = v.x < 0.f ? m.x : r.x; o.y = v.y < 0.f ? m.y : r.y; return o;
}

__device__ __forceinline__ float bf_lo(unsigned w) { return __uint_as_float(w << 16); }
__device__ __forceinline__ float bf_hi(unsigned w) { return __uint_as_float(w & 0xffff0000u); }
__device__ __forceinline__ float sigmoid_f(float x) { return __builtin_amdgcn_rcpf(1.0f + __builtin_amdgcn_exp2f(-1.4426950408889634f * x)); }

struct EpiZ {
    static constexpr bool PERM = true, AFTER_DRAIN = false;
    bf16_t *Q, *Kb, *V, *XR, *YR, *G0, *G1; const float* b_gate;
    __device__ __forceinline__ void operator()(const f32x4 (&acc)[2][2][4][2], const Unit& u, int wr, int wc, int fr, int fq) const {
        const int pn = u.pn; bf16_t* base; int ldc, colt; const float* bias = nullptr;
        if (pn < 8)       { base = Q;  ldc = 2048; colt = pn * BM; }
        else if (pn < 10) { base = Kb; ldc = 512;  colt = (pn - 8) * BM; }
        else if (pn < 12) { base = V;  ldc = 512;  colt = (pn - 10) * BM; }
        else if (pn < 20) { base = XR; ldc = 2048; colt = (pn - 12) * BM; }
        else if (pn < 28) { base = YR; ldc = 2048; colt = (pn - 20) * BM; }
        else if (pn < 44) { base = G0; ldc = 4096; colt = (pn - 28) * BM; bias = b_gate + colt; }
        else              { base = G1; ldc = 4096; colt = (pn - 44) * BM; bias = b_gate + 4096 + colt; }
        const int row0 = u.pm * BM + wr * 64 + fr, col0 = colt + wc * 32 + 8 * fq, bc0 = wc * 32 + 8 * fq;
        const bool gate = bias != nullptr;
        f32x4 bv[2][2];
#pragma unroll
        for (int bj = 0; bj < 2; ++bj)
#pragma unroll
            for (int n = 0; n < 2; ++n) bv[bj][n] = gate ? *(const f32x4*)(bias + bc0 + bj * HALF + 4 * n) : (f32x4){0.f, 0.f, 0.f, 0.f};
#pragma unroll
        for (int ai = 0; ai < 2; ++ai)
#pragma unroll
            for (int m = 0; m < 4; ++m) { bf16_t* rowp = base + (size_t)(row0 + ai * HALF + m * 16) * ldc + col0;
#pragma unroll
                for (int bj = 0; bj < 2; ++bj) { f32x4 v0 = acc[ai][bj][m][0], v1 = acc[ai][bj][m][1];
                    if (gate) { v0 = v0 + bv[bj][0]; v1 = v1 + bv[bj][1];
#pragma unroll
                        for (int e = 0; e < 4; ++e) { v0[e] = sigmoid_f(v0[e]); v1[e] = sigmoid_f(v1[e]); } }
                    u32x4 w; w.x = cvt_pk_bf16(v0[0], v0[1]); w.y = cvt_pk_bf16(v0[2], v0[3]); w.z = cvt_pk_bf16(v1[0], v1[1]); w.w = cvt_pk_bf16(v1[2], v1[3]);
                    *(u32x4*)(rowp + bj * HALF) = w; } }
    }
};

struct EpiGate {
    static constexpr bool PERM = true, AFTER_DRAIN = false;
    bf16_t* O; const bf16_t* G; const bf16_t* ADD; int ldc;
    __device__ __forceinline__ void operator()(const f32x4 (&acc)[2][2][4][2], const Unit& u, int wr, int wc, int fr, int fq) const {
        const int row0 = u.pm * BM + wr * 64 + fr, col0 = u.pn * BM + wc * 32 + 8 * fq;
#pragma unroll
        for (int ai = 0; ai < 2; ++ai)
#pragma unroll
            for (int m = 0; m < 4; ++m) { const size_t off = (size_t)(row0 + ai * HALF + m * 16) * ldc + col0;
                u32x4 g[2], a[2];
#pragma unroll
                for (int bj = 0; bj < 2; ++bj) { g[bj] = *(const u32x4*)(G + off + bj * HALF); a[bj] = ADD ? *(const u32x4*)(ADD + off + bj * HALF) : (u32x4){0u, 0u, 0u, 0u}; }
#pragma unroll
                for (int bj = 0; bj < 2; ++bj) { const f32x4 v0 = acc[ai][bj][m][0], v1 = acc[ai][bj][m][1]; u32x4 w;
                    w.x = cvt_pk_bf16(bf_lo(a[bj].x) + bf_lo(g[bj].x) * v0[0], bf_hi(a[bj].x) + bf_hi(g[bj].x) * v0[1]);
                    w.y = cvt_pk_bf16(bf_lo(a[bj].y) + bf_lo(g[bj].y) * v0[2], bf_hi(a[bj].y) + bf_hi(g[bj].y) * v0[3]);
                    w.z = cvt_pk_bf16(bf_lo(a[bj].z) + bf_lo(g[bj].z) * v1[0], bf_hi(a[bj].z) + bf_hi(g[bj].z) * v1[1]);
                    w.w = cvt_pk_bf16(bf_lo(a[bj].w) + bf_lo(g[bj].w) * v1[2], bf_hi(a[bj].w) + bf_hi(g[bj].w) * v1[3]);
                    *(u32x4*)(O + off + bj * HALF) = w; } }
    }
};

struct EpiResF32 {
    static constexpr bool PERM = false, AFTER_DRAIN = false;
    const float* B0; const float* B1; int split; float* out; int ldc;
    __device__ __forceinline__ void operator()(const f32x4 (&acc)[2][2][4][2], const Unit& u, int wr, int wc, int fr, int fq) const {
        const int rt0 = u.pm * BM; const float* bs = rt0 < split ? B0 + (size_t)rt0 * ldc : B1 + (size_t)(rt0 - split) * ldc; float* ob = out + (size_t)rt0 * ldc;
        const int col0 = u.pn * BM + wc * 32 + 4 * fq;
#pragma unroll
        for (int ai = 0; ai < 2; ++ai)
#pragma unroll
            for (int m = 0; m < 4; ++m) { const size_t off = (size_t)(wr * 64 + fr + ai * HALF + m * 16) * ldc + col0;
                f32x4 b[2][2];
#pragma unroll
                for (int bj = 0; bj < 2; ++bj)
#pragma unroll
                    for (int n = 0; n < 2; ++n) b[bj][n] = *(const f32x4*)(bs + off + bj * HALF + n * 16);
#pragma unroll
                for (int bj = 0; bj < 2; ++bj)
#pragma unroll
                    for (int n = 0; n < 2; ++n) *(f32x4*)(ob + off + bj * HALF + n * 16) = b[bj][n] + acc[ai][bj][m][n]; }
    }
};

struct EpiRelu2 {
    static constexpr bool PERM = true, AFTER_DRAIN = false;
    bf16_t* O; int ldc;
    __device__ __forceinline__ void operator()(const f32x4 (&acc)[2][2][4][2], const Unit& u, int wr, int wc, int fr, int fq) const {
        const int row0 = u.pm * BM + wr * 64 + fr, col0 = u.pn * BM + wc * 32 + 8 * fq;
#pragma unroll
        for (int ai = 0; ai < 2; ++ai)
#pragma unroll
            for (int m = 0; m < 4; ++m) { bf16_t* rowp = O + (size_t)(row0 + ai * HALF + m * 16) * ldc + col0;
#pragma unroll
                for (int bj = 0; bj < 2; ++bj) { f32x4 v0 = acc[ai][bj][m][0], v1 = acc[ai][bj][m][1];
#pragma unroll
                    for (int e = 0; e < 4; ++e) { const float a = fmaxf(v0[e], 0.f), b = fmaxf(v1[e], 0.f); v0[e] = a * a; v1[e] = b * b; }
                    u32x4 w; w.x = cvt_pk_bf16(v0[0], v0[1]); w.y = cvt_pk_bf16(v0[2], v0[3]); w.z = cvt_pk_bf16(v1[0], v1[1]); w.w = cvt_pk_bf16(v1[2], v1[3]);
                    *(u32x4*)(rowp + bj * HALF) = w; } }
    }
};
template <class Epi, class Sched, bool ALIGN_EPI = false, bool SP2 = false>
__device__ __forceinline__ void gemm_phase(PG8_LAS unsigned char* lds, const Gemm g, const Sched& S, const Epi& E) {
    const int tid = threadIdx.x, wid = __builtin_amdgcn_readfirstlane(tid >> 6), lane = tid & 63, wr = wid >> 2, wc = wid & 3, fr = lane & 15, fq = lane >> 4;
    const int K = g.K, nt = K / BK;
    unsigned voffA[2], voffB[2];
#pragma unroll
    for (int i = 0; i < 2; ++i) { int R, C; stage_rc(tid * 16 + i * 8192, R, C); const int Rb = Epi::PERM ? ((R & ~31) + perm32(R & 31)) : R;
        voffA[i] = (unsigned)(R * K + C) * 2u; voffB[i] = (unsigned)(Rb * K + C) * 2u; }
    const size_t kstep = (size_t)(BK * 2);
    const size_t hstep = (size_t)HALF * K * 2;
    const size_t tstep = 2 * hstep;
    const unsigned ldsw = (unsigned)wid * 1024u;
    const int aoff = lds_byte(wr * 64 + fr, fq * 8), boff = lds_byte(wc * 32 + fr, fq * 8);
#define PG8_SA(b, h) (((b) * 2 + (h)) * HTB)
#define PG8_SB(b, h) ((4 + (b) * 2 + (h)) * HTB)
#define PG8_STAGE(bufoff, gbase, voff) do { _Pragma("unroll") for (int _i = 0; _i < 2; ++_i) \
        __builtin_amdgcn_global_load_lds((const unsigned*)((const char*)(gbase) + (voff)[_i]), (PG8_LAS unsigned*)(lds + (bufoff) + ldsw + _i * 8192), 16, 0, 0); } while (0)
#define PG8_LDA(dst, b, h) do { _Pragma("unroll") for (int m = 0; m < 4; ++m) _Pragma("unroll") for (int k = 0; k < 2; ++k) dst[m][k] = *(const PG8_LAS bf16x8*)(lds + PG8_SA(b, h) + aoff + m * 2048 + k * 1024); } while (0)
#define PG8_LDB(dst, b, h) do { _Pragma("unroll") for (int n = 0; n < 2; ++n) _Pragma("unroll") for (int k = 0; k < 2; ++k) dst[n][k] = *(const PG8_LAS bf16x8*)(lds + PG8_SB(b, h) + boff + n * 2048 + k * 1024); } while (0)
#define PG8_MMA(ai, bj, At, Bt) do { __builtin_amdgcn_s_setprio(1); _Pragma("unroll") for (int m = 0; m < 4; ++m) _Pragma("unroll") for (int n = 0; n < 2; ++n) _Pragma("unroll") for (int k = 0; k < 2; ++k) \
        acc[ai][bj][m][n] = __builtin_amdgcn_mfma_f32_16x16x32_bf16(Bt[n][k], At[m][k], acc[ai][bj][m][n], 0, 0, 0); __builtin_amdgcn_s_setprio(0); } while (0)
#define PG8_WAIT_V(n) asm volatile("s_waitcnt vmcnt(" #n ")" ::: "memory")
#define PG8_WAIT_L(n) asm volatile("s_waitcnt lgkmcnt(" #n ")" ::: "memory")
#define PG8_BAR __builtin_amdgcn_s_barrier()
#define PG8_SCHED __builtin_amdgcn_sched_barrier(0)
    Unit cur, nxt; int ui = 0;
    if (!S.next(0, cur)) return;
    f32x4 acc[2][2][4][2];
#pragma unroll
    for (int a = 0; a < 2; ++a)
#pragma unroll
        for (int b = 0; b < 2; ++b)
#pragma unroll
            for (int m = 0; m < 4; ++m)
#pragma unroll
                for (int n = 0; n < 2; ++n) acc[a][b][m][n] = (f32x4){0.f, 0.f, 0.f, 0.f};
    bf16x8 At[4][2], B0[2][2], B1[2][2];
    const char* cA = (const char*)g.A + (size_t)cur.pm * tstep; const char* cB = (const char*)g.Bt + (size_t)cur.pn * tstep;
    S.a_ready(cur);
    if constexpr (SP2) {
        PG8_STAGE(PG8_SB(0, 0), cB, voffB); PG8_STAGE(PG8_SB(0, 1), cB + hstep, voffB); PG8_STAGE(PG8_SA(0, 0), cA, voffA); PG8_STAGE(PG8_SA(0, 1), cA + hstep, voffA);
        if (wr == 1) PG8_BAR;
        PG8_WAIT_V(2); PG8_BAR;
        PG8_STAGE(PG8_SB(1, 0), cB + kstep, voffB); PG8_STAGE(PG8_SA(1, 0), cA + kstep, voffA); PG8_STAGE(PG8_SB(1, 1), cB + hstep + kstep, voffB);
        PG8_WAIT_V(6); PG8_BAR;
    } else {
        PG8_STAGE(PG8_SB(0, 0), cB, voffB); PG8_STAGE(PG8_SA(0, 0), cA, voffA); PG8_STAGE(PG8_SB(0, 1), cB + hstep, voffB); PG8_STAGE(PG8_SA(0, 1), cA + hstep, voffA);
        if (wr == 1) PG8_BAR;
        PG8_WAIT_V(4); PG8_BAR;
        PG8_STAGE(PG8_SB(1, 0), cB + kstep, voffB); PG8_STAGE(PG8_SA(1, 0), cA + kstep, voffA); PG8_STAGE(PG8_SB(1, 1), cB + hstep + kstep, voffB);
        PG8_WAIT_V(6); PG8_BAR;
    }
    for (;;) {
        const bool has_next = S.next(ui + 1, nxt);
        const char* nA = has_next ? (const char*)g.A + (size_t)nxt.pm * tstep : cA; const char* nB = has_next ? (const char*)g.Bt + (size_t)nxt.pn * tstep : cB;
        for (int t = 0; t < nt; t += 2) {
            const bool last = (t == nt - 2);
            const char* a1 = cA + (size_t)(t + 1) * kstep;
            const char* a2 = last ? nA : cA + (size_t)(t + 2) * kstep; const char* b2 = last ? nB : cB + (size_t)(t + 2) * kstep;
            const char* a3 = a2 + kstep; const char* b3 = b2 + kstep;
            if (last && has_next) S.a_ready(nxt);
            if constexpr (SP2) {
            PG8_LDB(B0, 0, 0); PG8_LDB(B1, 0, 1); PG8_SCHED; PG8_LDA(At, 0, 0); PG8_STAGE(PG8_SA(1, 1), a1 + hstep, voffA);
            PG8_WAIT_V(8); PG8_WAIT_L(0); PG8_BAR; PG8_MMA(0, 0, At, B0); PG8_MMA(0, 1, At, B1); PG8_BAR; PG8_SCHED;
            PG8_LDA(At, 0, 1); PG8_STAGE(PG8_SB(0, 0), b2, voffB); PG8_STAGE(PG8_SB(0, 1), b2 + hstep, voffB); PG8_STAGE(PG8_SA(0, 0), a2, voffA);
            PG8_WAIT_V(8); PG8_WAIT_L(0); PG8_BAR; PG8_MMA(1, 0, At, B0); PG8_MMA(1, 1, At, B1); PG8_BAR; PG8_SCHED;
            PG8_LDB(B0, 1, 0); PG8_LDB(B1, 1, 1); PG8_SCHED; PG8_LDA(At, 1, 0); PG8_STAGE(PG8_SA(0, 1), a2 + hstep, voffA);
            PG8_WAIT_V(8); PG8_WAIT_L(0); PG8_BAR; PG8_MMA(0, 0, At, B0); PG8_MMA(0, 1, At, B1); PG8_BAR; PG8_SCHED;
            PG8_LDA(At, 1, 1); PG8_STAGE(PG8_SB(1, 0), b3, voffB); PG8_STAGE(PG8_SB(1, 1), b3 + hstep, voffB); PG8_STAGE(PG8_SA(1, 0), a3, voffA);
            PG8_WAIT_V(8); PG8_WAIT_L(0); PG8_BAR; PG8_MMA(1, 0, At, B0); PG8_MMA(1, 1, At, B1); PG8_BAR; PG8_SCHED;
            } else {
            PG8_LDB(B0, 0, 0); PG8_SCHED; PG8_LDA(At, 0, 0); PG8_STAGE(PG8_SA(1, 1), a1 + hstep, voffA);
            PG8_WAIT_L(8); PG8_BAR; PG8_WAIT_L(0); PG8_MMA(0, 0, At, B0); PG8_BAR; PG8_SCHED;
            PG8_LDB(B1, 0, 1); PG8_STAGE(PG8_SB(0, 0), b2, voffB);
            PG8_BAR; PG8_WAIT_L(0); PG8_MMA(0, 1, At, B1); PG8_BAR;
            PG8_LDA(At, 0, 1); PG8_STAGE(PG8_SA(0, 0), a2, voffA);
            PG8_BAR; PG8_WAIT_L(0); PG8_MMA(1, 0, At, B0); PG8_BAR; PG8_SCHED;
            PG8_STAGE(PG8_SB(0, 1), b2 + hstep, voffB);
            PG8_WAIT_V(6); PG8_BAR; PG8_MMA(1, 1, At, B1); PG8_BAR;
            PG8_LDB(B0, 1, 0); PG8_SCHED; PG8_LDA(At, 1, 0); PG8_STAGE(PG8_SA(0, 1), a2 + hstep, voffA);
            PG8_WAIT_L(8); PG8_BAR; PG8_WAIT_L(0); PG8_MMA(0, 0, At, B0); PG8_BAR; PG8_SCHED;
            PG8_LDB(B1, 1, 1); PG8_STAGE(PG8_SB(1, 0), b3, voffB);
            PG8_BAR; PG8_WAIT_L(0); PG8_MMA(0, 1, At, B1); PG8_BAR;
            PG8_LDA(At, 1, 1); PG8_STAGE(PG8_SA(1, 0), a3, voffA);
            PG8_BAR; PG8_WAIT_L(0); PG8_MMA(1, 0, At, B0); PG8_BAR; PG8_SCHED;
            PG8_STAGE(PG8_SB(1, 1), b3 + hstep, voffB);
            PG8_WAIT_V(6); PG8_BAR; PG8_MMA(1, 1, At, B1); PG8_BAR;
            }
        }
        if constexpr (ALIGN_EPI) { if (wr == 0) PG8_BAR; }
        if constexpr (!Epi::AFTER_DRAIN) { E(acc, cur, wr, wc, fr, fq); S.done(cur); }
        if (!has_next) break;
#pragma unroll
        for (int a = 0; a < 2; ++a)
#pragma unroll
            for (int b = 0; b < 2; ++b)
#pragma unroll
                for (int m = 0; m < 4; ++m)
#pragma unroll
                    for (int n = 0; n < 2; ++n) acc[a][b][m][n] = (f32x4){0.f, 0.f, 0.f, 0.f};
        cur = nxt; cA = nA; cB = nB; ++ui;
        if constexpr (ALIGN_EPI) { if (wr == 1) PG8_BAR; }
    }
    PG8_WAIT_V(0);
    if constexpr (!ALIGN_EPI) { if (wr == 0) PG8_BAR; }
    PG8_BAR;
    if constexpr (Epi::AFTER_DRAIN) { E.fused(acc, cur, wr, wc, fr, fq, lds, wid, lane); S.done(cur); }
#undef PG8_SA
#undef PG8_SB
#undef PG8_STAGE
#undef PG8_LDA
#undef PG8_LDB
#undef PG8_MMA
#undef PG8_WAIT_V
#undef PG8_WAIT_L
#undef PG8_BAR
#undef PG8_SCHED
}
}
namespace attn {
using bf16 = unsigned short;
constexpr int   D = 128, NW = 8, QBLK = 32, KVBLK = 64;
constexpr float SCALE = 0.088388347648318440f;
constexpr float THR = 8.f;
constexpr int SDEPTH = 1;
constexpr int LDQ = 2048, LDK = 512, LDO = 2048;
constexpr size_t SHM_V = KVBLK * D * 2, SHM_K = KVBLK * D * 2, SHM_ATTN = 2 * SHM_V + 2 * SHM_K + NW * 64 * 4;
using bf16x8 = __attribute__((ext_vector_type(8))) short;
using s16x4  = __attribute__((ext_vector_type(4))) short;
using f32x16 = __attribute__((ext_vector_type(16))) float;
using f32x8  = __attribute__((ext_vector_type(8))) float;
using u32x4  = __attribute__((ext_vector_type(4))) unsigned;
#define KSWZ(row, colB) ((row) * 256 + ((colB) ^ (((row) & 7) << 4)))
#define SBAR() __builtin_amdgcn_sched_barrier(0)
__device__ __forceinline__ int crow(int r, int hi) { return (r & 3) + 8 * (r >> 2) + 4 * hi; }
__device__ __forceinline__ unsigned cvtpk(float lo, float hi) {
  unsigned r; asm volatile("v_cvt_pk_bf16_f32 %0, %1, %2" : "=v"(r) : "v"(lo), "v"(hi)); return r;
}
struct StageB { using T = bf16x8;
  __device__ static __forceinline__ T ld8(const bf16* p) { return *reinterpret_cast<const bf16x8*>(p); }
  __device__ static __forceinline__ bf16x8 tobf(T x) { return x; } };
__device__ __forceinline__ void partialSM(f32x16& p0, f32x16& p1, float& m_reg, float& mn, float& alpha) {
  constexpr float C = SCALE * 1.4426950408889634f;
  float pmax = p0[0]; for (int r = 1; r < 16; ++r) pmax = fmaxf(pmax, p0[r]); for (int r = 0; r < 16; ++r) pmax = fmaxf(pmax, p1[r]);
  { auto rr = __builtin_amdgcn_permlane32_swap(__float_as_uint(pmax), __float_as_uint(pmax), false, false);
    pmax = fmaxf(__uint_as_float(rr[0]), __uint_as_float(rr[1])); }
  if (__builtin_expect(__all(pmax - m_reg <= THR / SCALE), 1)) { mn = m_reg; alpha = 1.f; }
  else { mn = fmaxf(m_reg, pmax); alpha = __builtin_amdgcn_exp2f((m_reg - mn) * C); m_reg = mn; }
  float mnC = -mn * C;
  for (int r = 0; r < 16; ++r) p0[r] = fmaf(p0[r], C, mnC); for (int r = 0; r < 16; ++r) p1[r] = fmaf(p1[r], C, mnC);
  for (int r = 0; r < 16; ++r) p0[r] = __builtin_amdgcn_exp2f(p0[r]);
}
__device__ __forceinline__ void finishSM(f32x16& p0, f32x16& p1, float alpha, float& l_reg, bf16x8& pa0, bf16x8& pa1, bf16x8& pa2, bf16x8& pa3) {
  for (int r = 0; r < 16; ++r) p1[r] = __builtin_amdgcn_exp2f(p1[r]);
  float ps = 0; for (int r = 0; r < 16; ++r) ps += p0[r]; for (int r = 0; r < 16; ++r) ps += p1[r];
  { auto rr = __builtin_amdgcn_permlane32_swap(__float_as_uint(ps), __float_as_uint(ps), false, false);
    ps = __uint_as_float(rr[0]) + __uint_as_float(rr[1]); }
  l_reg = l_reg * alpha + ps;
#define PK4(P, BASE, OUT) do { unsigned a0 = cvtpk(P[BASE + 0], P[BASE + 1]), a1 = cvtpk(P[BASE + 2], P[BASE + 3]);   \
    unsigned b0 = cvtpk(P[BASE + 4], P[BASE + 5]), b1 = cvtpk(P[BASE + 6], P[BASE + 7]);                              \
    auto r0 = __builtin_amdgcn_permlane32_swap(a0, b0, false, false); auto r1 = __builtin_amdgcn_permlane32_swap(a1, b1, false, false); \
    u32x4 w = {r0[0], r1[0], r0[1], r1[1]}; OUT = *reinterpret_cast<bf16x8*>(&w); } while (0)
  PK4(p0, 0, pa0); PK4(p0, 8, pa1); PK4(p1, 0, pa2); PK4(p1, 8, pa3);
#undef PK4
}
__device__ __forceinline__ void qkt(f32x16& p0, f32x16& p1, const bf16* Ks, const bf16x8* qr, int r32, int hi) {
  p0 = f32x16{}; p1 = f32x16{};
  for (int d0 = 0; d0 < 8; ++d0) { int cb = (d0 * 16 + hi * 8) * 2;
    bf16x8 b0 = *reinterpret_cast<const bf16x8*>((const char*)Ks + KSWZ(r32, cb));
    bf16x8 b1 = *reinterpret_cast<const bf16x8*>((const char*)Ks + KSWZ(32 + r32, cb));
    p0 = __builtin_amdgcn_mfma_f32_32x32x16_bf16(b0, qr[d0], p0, 0, 0, 0);
    p1 = __builtin_amdgcn_mfma_f32_32x32x16_bf16(b1, qr[d0], p1, 0, 0, 0); }
}
__device__ __forceinline__ int v_st(int k, int c) { const int kk = (k & ~0xC) | ((k & 4) << 1) | ((k & 8) >> 1); return ((kk >> 3) * 4 + (c >> 5)) * 512 + ((kk & 7) * 32 + (c & 31)) * 2; }
__device__ __forceinline__ int v_rd_base(int lane) { return ((lane & 3) << 3) | (((lane >> 2) & 3) << 6) | (((lane >> 4) & 1) << 5) | (((lane >> 5) & 1) << 8); }
constexpr int v_rd_off(int d0, int ks, int half) { return d0 * 512 + ks * 4096 + half * 2048; }
template <int OFF> __device__ __forceinline__ s16x4 tr_read(int vb) {
  s16x4 r; asm volatile("ds_read_b64_tr_b16 %0, %1 offset:%2" : "=&v"(r) : "v"(vb), "i"(OFF) : "memory"); return r;
}
template <int D0> __device__ __forceinline__ void pv_one(f32x16& od, int vb, bf16x8 pa0, bf16x8 pa1, bf16x8 pa2, bf16x8 pa3) {
  const s16x4 l0 = tr_read<v_rd_off(D0, 0, 0)>(vb), h0 = tr_read<v_rd_off(D0, 0, 1)>(vb), l1 = tr_read<v_rd_off(D0, 1, 0)>(vb), h1 = tr_read<v_rd_off(D0, 1, 1)>(vb);
  const s16x4 l2 = tr_read<v_rd_off(D0, 2, 0)>(vb), h2 = tr_read<v_rd_off(D0, 2, 1)>(vb), l3 = tr_read<v_rd_off(D0, 3, 0)>(vb), h3 = tr_read<v_rd_off(D0, 3, 1)>(vb);
  asm volatile("s_waitcnt lgkmcnt(0)" ::: "memory"); SBAR();
#define PK(L, H) (bf16x8){L[0], L[1], L[2], L[3], H[0], H[1], H[2], H[3]}
  od = __builtin_amdgcn_mfma_f32_32x32x16_bf16(pa0, PK(l0, h0), od, 0, 0, 0);
  od = __builtin_amdgcn_mfma_f32_32x32x16_bf16(pa1, PK(l1, h1), od, 0, 0, 0);
  od = __builtin_amdgcn_mfma_f32_32x32x16_bf16(pa2, PK(l2, h2), od, 0, 0, 0);
  od = __builtin_amdgcn_mfma_f32_32x32x16_bf16(pa3, PK(l3, h3), od, 0, 0, 0);
#undef PK
}
__device__ __forceinline__ void pv_d0(f32x16* o, int vb, bf16x8 pa0, bf16x8 pa1, bf16x8 pa2, bf16x8 pa3) {
  pv_one<0>(o[0], vb, pa0, pa1, pa2, pa3); pv_one<1>(o[1], vb, pa0, pa1, pa2, pa3); pv_one<2>(o[2], vb, pa0, pa1, pa2, pa3); pv_one<3>(o[3], vb, pa0, pa1, pa2, pa3);
}

__device__ __forceinline__ void attn_dense_body(const bf16* Qb, const bf16* __restrict__ Kh, const bf16* __restrict__ Vh,
                                                bf16* Ob, int seq, char* lds) {
  using St = StageB; using SQ = StageB;
  int tid_ = threadIdx.x; asm volatile("" : "+v"(tid_));
  const int tid = tid_, wid = __builtin_amdgcn_readfirstlane(tid >> 6), lane = tid & 63, r32 = lane & 31, hi = lane >> 5;
  bf16* V_lds = (bf16*)lds; bf16* K_lds = (bf16*)(lds + 2 * SHM_V);
  float* ws = (float*)(lds + 2 * SHM_V + 2 * SHM_K) + wid * 64; float* li_l = ws; float* al_l = ws + 32;
  float m_reg = -1e30f, l_reg = 0; f32x16 o[4] = {}; bf16x8 qr[8];
  const bf16* Qw = Qb + (long)(wid * QBLK + r32) * LDQ + hi * 8;
#pragma unroll
  for (int d0 = 0; d0 < 8; ++d0) qr[d0] = SQ::tobf(SQ::ld8(Qw + d0 * 16));
  const int sr = tid >> 4, sc = (tid & 15) * 8, vst0 = v_st(sr, sc), vst1 = v_st(32 + sr, sc);
  const int vb0 = (int)(uintptr_t)V_lds + v_rd_base(lane);
  struct { typename St::T vs0, vs1, ks0, ks1; } sr_[SDEPTH];
#define SLOAD(i, k0) do { sr_[i].vs0 = St::ld8(&Vh[(long)((k0) + sr) * LDK + sc]); sr_[i].vs1 = St::ld8(&Vh[(long)((k0) + 32 + sr) * LDK + sc]); \
    sr_[i].ks0 = St::ld8(&Kh[(long)((k0) + sr) * LDK + sc]); sr_[i].ks1 = St::ld8(&Kh[(long)((k0) + 32 + sr) * LDK + sc]); } while (0)
#define SWRITE(b, i) do { *(bf16x8*)((char*)V_lds + (b) * SHM_V + vst0) = St::tobf(sr_[i].vs0);          \
    *(bf16x8*)((char*)V_lds + (b) * SHM_V + vst1) = St::tobf(sr_[i].vs1); int kc = sc * 2;               \
    *(bf16x8*)((char*)K_lds + (b) * SHM_K + KSWZ(sr, kc)) = St::tobf(sr_[i].ks0);                       \
    *(bf16x8*)((char*)K_lds + (b) * SHM_K + KSWZ(32 + sr, kc)) = St::tobf(sr_[i].ks1); } while (0)
#define SWAIT() do { if constexpr (SDEPTH == 2) asm volatile("s_waitcnt vmcnt(4)" ::: "memory"); else asm volatile("s_waitcnt vmcnt(0)" ::: "memory"); } while (0)
#define RESC(a) do { if (__any((a) < 1.f)) { if (hi == 0) al_l[r32] = (a); asm volatile("s_waitcnt lgkmcnt(0)" ::: "memory"); \
    for (int d = 0; d < 4; ++d) for (int r = 0; r < 16; ++r) o[d][r] *= al_l[crow(r, hi)]; } } while (0)
  f32x16 pA0, pA1, pB0, pB1; float mnA, mnB, alA, alB; bf16x8 pa0, pa1, pa2, pa3; const int NT = seq / KVBLK;
  constexpr int SE = 0, SO = SDEPTH - 1;
  SLOAD(SE, 0); asm volatile("s_waitcnt vmcnt(0)" ::: "memory"); SWRITE(0, SE); __syncthreads();
  qkt(pA0, pA1, K_lds, qr, r32, hi); partialSM(pA0, pA1, m_reg, mnA, alA);
  SLOAD(SO, KVBLK); if constexpr (SDEPTH == 2) { if (2 < NT) SLOAD(SE, 2 * KVBLK); }
  SWAIT(); SWRITE(1, SO); __syncthreads();
  for (int j = 1; j + 1 < NT; j += 2) {
    SBAR(); qkt(pB0, pB1, (bf16*)((char*)K_lds + SHM_K), qr, r32, hi);
    finishSM(pA0, pA1, alA, l_reg, pa0, pa1, pa2, pa3); SBAR();
    SLOAD(SO, (j + SDEPTH) * KVBLK); SBAR();
    pv_d0(o, vb0, pa0, pa1, pa2, pa3); partialSM(pB0, pB1, m_reg, mnB, alB);
    __syncthreads(); SWAIT(); SWRITE(0, SE);
    RESC(alB); __syncthreads();
    SBAR(); qkt(pA0, pA1, K_lds, qr, r32, hi);
    finishSM(pB0, pB1, alB, l_reg, pa0, pa1, pa2, pa3); SBAR();
    if (SDEPTH == 1 || j + 3 < NT) SLOAD(SE, (j + 1 + SDEPTH) * KVBLK); SBAR();
    pv_d0(o, vb0 + (int)SHM_V, pa0, pa1, pa2, pa3); partialSM(pA0, pA1, m_reg, mnA, alA);
    __syncthreads(); SWAIT(); SWRITE(1, SO);
    RESC(alA); __syncthreads();
  }
  SBAR(); qkt(pB0, pB1, (bf16*)((char*)K_lds + SHM_K), qr, r32, hi);
  finishSM(pA0, pA1, alA, l_reg, pa0, pa1, pa2, pa3); SBAR();
  pv_d0(o, vb0, pa0, pa1, pa2, pa3); partialSM(pB0, pB1, m_reg, mnB, alB);
  __syncthreads(); RESC(alB);
  finishSM(pB0, pB1, alB, l_reg, pa0, pa1, pa2, pa3); SBAR();
  pv_d0(o, vb0 + (int)SHM_V, pa0, pa1, pa2, pa3);
  if (hi == 0) li_l[r32] = l_reg; asm volatile("s_waitcnt lgkmcnt(0)" ::: "memory");
  float rli[16];
#pragma unroll
  for (int r = 0; r < 16; ++r) rli[r] = __builtin_amdgcn_rcpf(li_l[crow(r, hi)]);
  __syncthreads();
  char* ost = lds + wid * 8192;
#pragma unroll
  for (int r = 0; r < 16; ++r) { const int orow = crow(r, hi);
#pragma unroll
    for (int d0 = 0; d0 < 4; ++d0) { const float v = o[d0][r] * rli[r]; unsigned u = __float_as_uint(v); u = (u + 0x7fffu + ((u >> 16) & 1u)) >> 16;
      *(unsigned short*)(ost + orow * 256 + (d0 * 32 + r32) * 2) = (unsigned short)u; } }
  asm volatile("s_waitcnt lgkmcnt(0)" ::: "memory");
  bf16* Ow = Ob + (long)(wid * QBLK) * LDO;
#pragma unroll
  for (int i = 0; i < 8; ++i) { const int row = (lane >> 4) + 4 * i, ch = lane & 15;
    const u32x4 v = *(const u32x4*)(ost + row * 256 + ch * 16); *(u32x4*)(Ow + (long)row * LDO + ch * 8) = v; }
  __syncthreads();
#undef SLOAD
#undef SWRITE
#undef SWAIT
#undef RESC
}
}
constexpr int NWAVES = 8;
#ifndef MK_PER_PHASE
#define MK_PER_PHASE 0
#endif
#ifndef MK_STAGE
#define MK_STAGE 9
#endif

constexpr int D = 4096, NTOK_P = 4 * 4096, NTOK_S = 8192, NTOK = NTOK_P + NTOK_S;
constexpr int SEQ_P = 4096, SEQ_S = 8192;
constexpr int HD = 128, NQH = 16, NKVH = 4, AW = NQH * HD  , KVW = NKVH * HD  ;
constexpr int DR = 2048, LRU_NB = 16, LRU_BW = 128;
constexpr int FF = 4 * D, INW = AW + 2 * KVW + 2 * DR + 2 * D;
constexpr float NORM_EPS = 1e-6f;
constexpr int MLP_CHUNKS = 2, MLP_ROWS = NTOK / MLP_CHUNKS;
constexpr int LCH = 128, NCHUNK = NTOK / LCH;

constexpr size_t MiB = 1u << 20;
constexpr size_t WS_CTL = 0, CTL_ZERO_BYTES = 1 * MiB;
constexpr size_t WS_AGG = 1 * MiB;
constexpr size_t WS_CARRY = 8 * MiB;
constexpr size_t WS_WIN = 12 * MiB, WS_WATT = 132 * MiB, WS_WRNN = 148 * MiB, WS_WOUT = 164 * MiB, WS_WUP = 196 * MiB, WS_WDN = 324 * MiB;
constexpr size_t WS_A = 452 * MiB;
constexpr size_t WS_H1 = WS_A, WS_ATT = WS_A, WS_REC = WS_A + 96 * MiB, WS_HM = WS_A;
constexpr size_t WS_B = 644 * MiB;
constexpr size_t WS_Q = WS_B, WS_K = WS_B + 96 * MiB, WS_V = WS_B + 120 * MiB, WS_XR = WS_B + 144 * MiB, WS_YR = WS_B + 240 * MiB;
constexpr size_t WS_MRG = WS_B, WS_HID = WS_B;
constexpr size_t WS_T1 = 1028 * MiB;
constexpr size_t WS_WF = 1220 * MiB;
constexpr size_t WS_END = 1222 * MiB;
static_assert(WS_WDN + (size_t)D * FF * 2 <= WS_A && WS_YR + (size_t)NTOK * DR * 2 <= WS_T1 && WS_HID + (size_t)MLP_ROWS * FF * 2 <= WS_T1 + 0 * MiB + 0 && WS_T1 + (size_t)NTOK * D * 2 <= WS_WF, "d_ws map");
constexpr int CW_TMO = 0, CW_CODE = 1;
constexpr int CW_BAR = 4096;

constexpr int RING_OFF = 0, RING_BYTES = 131072;
constexpr int LDSCTL_OFF = RING_BYTES, MISC_OFF = LDSCTL_OFF + 320;
constexpr int LDS_BYTES = 147456;
static_assert(MISC_OFF + 128 <= LDS_BYTES, "LDS map");
#define GAS __attribute__((address_space(1)))
#define LAS __attribute__((address_space(3)))
typedef unsigned short bf16;
typedef unsigned v4u __attribute__((ext_vector_type(4)));
typedef float f32x4 __attribute__((ext_vector_type(4)));
typedef short bf16x8 __attribute__((ext_vector_type(8)));
typedef GAS unsigned gu32;
typedef GAS unsigned long long gu64;
#define RLX_AGENT __ATOMIC_RELAXED, __HIP_MEMORY_SCOPE_AGENT
#define LDS_WAIT() asm volatile("s_waitcnt lgkmcnt(0)" ::: "memory")
#define VM_WAIT() asm volatile("s_waitcnt vmcnt(0)" ::: "memory")
__device__ __forceinline__ unsigned long long rt() { return __builtin_amdgcn_s_memrealtime(); }
__device__ __forceinline__ unsigned f2bf(float f) { unsigned u = __builtin_bit_cast(unsigned, f); return (u + 0x7fffu + ((u >> 16) & 1u)) >> 16; }
__device__ __forceinline__ unsigned pk2(float lo, float hi) { return f2bf(lo) | (f2bf(hi) << 16); }

#define XB_TMO      128
#define XB_XCNT(j)  (256  + 64 * (j))
#define XB_XSUB(j)  (1280 + 64 * (j))
#define XB_XGEN(j)  (2304 + 64 * (j))
#define XB_TOP      3328
#define XB_TOPGEN   3392
#define XCD_BAR_WORDS 3456
#define XB_SPIN_CAP (1u << 18)

__device__ __forceinline__ unsigned xb_ld(unsigned* p)              { return __hip_atomic_load(p, __ATOMIC_RELAXED, __HIP_MEMORY_SCOPE_AGENT); }
__device__ __forceinline__ unsigned xb_add(unsigned* p, unsigned v) { return __hip_atomic_fetch_add(p, v, __ATOMIC_RELAXED, __HIP_MEMORY_SCOPE_AGENT); }
__device__ __forceinline__ unsigned xb_xcc_id() { return (unsigned)__builtin_amdgcn_s_getreg((3 << 11) | 20) & 0xFu; }
#define XB_SPIN(cond, bar) do { unsigned _sp = 0; while (cond) { __builtin_amdgcn_s_sleep(1); \
    if ((++_sp & 255u) == 0u) { if (xb_ld(&(bar)[XB_TMO])) break; if (_sp > XB_SPIN_CAP) { atomicAdd(&(bar)[XB_TMO], 1u); break; } } } } while (0)

struct XcdBarrier {
    unsigned* bar; unsigned x;
    volatile LAS unsigned* st;
};

__device__ __forceinline__ XcdBarrier xcd_barrier_post(unsigned* bar, volatile LAS unsigned* st) {
    XcdBarrier b; b.bar = bar; b.x = xb_xcc_id(); b.st = st;
    if (threadIdx.x == 0) (void)xb_add(&bar[XB_XCNT(b.x)], 1u);
    return b;
}
__device__ __forceinline__ void xcd_barrier_complete(unsigned* bar, unsigned x, unsigned& nloc, unsigned& nx) {
    const unsigned G = gridDim.x * gridDim.y * gridDim.z;
    unsigned sum, cnt, mine, sp = 0u;
    for (;;) {
        sum = 0u; cnt = 0u; mine = 0u;
#pragma unroll
        for (unsigned j = 0; j < 16; ++j) { const unsigned c = xb_ld(&bar[XB_XCNT(j)]); sum += c; cnt += (c > 0u) ? 1u : 0u; mine = (j == x) ? c : mine; }
        if (sum == G) break;
        __builtin_amdgcn_s_sleep(1);
        if ((++sp & 255u) == 0u) { if (xb_ld(&bar[XB_TMO])) break; if (sp > XB_SPIN_CAP) { atomicAdd(&bar[XB_TMO], 1u); break; } }
    }
    nloc = mine > 0u ? mine : 1u; nx = cnt > 0u ? cnt : 1u;
}

__device__ __forceinline__ void xcd_barrier(const XcdBarrier& b) {
    asm volatile("s_waitcnt vmcnt(0)" ::: "memory");
    __syncthreads();
    if (threadIdx.x == 0) {
        unsigned* bar = b.bar;
        __builtin_amdgcn_s_waitcnt(0);
        unsigned nloc = b.st[0], nx = b.st[1];
        if (nloc == 0u) { xcd_barrier_complete(bar, b.x, nloc, nx); b.st[0] = nloc; b.st[1] = nx; }
        const unsigned old = xb_add(&bar[XB_XSUB(b.x)], 1u);
        const unsigned gen = old / nloc;
        if (old + 1u == (gen + 1u) * nloc) {
            __builtin_amdgcn_fence(__ATOMIC_RELEASE, "agent");
            asm volatile("s_waitcnt vmcnt(0)" ::: "memory");
            const unsigned og = xb_add(&bar[XB_TOP], 1u);
            const unsigned tg = og / nx;
            if (og + 1u == (tg + 1u) * nx) xb_add(&bar[XB_TOPGEN], 1u);
            else XB_SPIN(xb_ld(&bar[XB_TOPGEN]) == tg, bar);
            __builtin_amdgcn_fence(__ATOMIC_ACQUIRE, "agent");
            xb_add(&bar[XB_XGEN(b.x)], 1u);
            asm volatile("s_waitcnt vmcnt(0)" ::: "memory");
        } else {
            XB_SPIN(xb_ld(&bar[XB_XGEN(b.x)]) == gen, bar);
            __builtin_amdgcn_fence(__ATOMIC_ACQUIRE, "agent");
            asm volatile("s_waitcnt vmcnt(0)" ::: "memory");
        }
    }
    __syncthreads();
}

struct Frame {
    LAS unsigned char* lds;
    volatile LAS unsigned* MISC;
    gu32* ctl;
    int tid, lane, wave;
    int vcu, G;
    const float* in[21]; float* out; unsigned char* ws;
};
__device__ __forceinline__ float wave_sum(float v) {
#pragma unroll
    for (int o = 1; o < 64; o <<= 1) v += __shfl_xor(v, o);
    return v;
}
__device__ __forceinline__ const float* xrow_ptr(const Frame& F, int row) { return row < NTOK_P ? F.in[0] + (size_t)row * D : F.in[1] + (size_t)(row - NTOK_P) * D; }

__device__ __forceinline__ void p0_transpose_item(const float* W, int K, int N, bf16* WT, LAS float* scr, int item, int lane) {
    const int nblk = N / 32, kb = item / nblk, nb = item % nblk, k0 = 64 * kb, n0 = 32 * nb;
#pragma unroll 8
    for (int i = 0; i < 32; ++i) { const int kk = 2 * i + (lane >> 5); scr[kk * 33 + (lane & 31)] = W[(size_t)(k0 + kk) * N + n0 + (lane & 31)]; }
    LDS_WAIT(); asm volatile("" ::: "memory");
    const int c = lane & 7;
#pragma unroll
    for (int j = 0; j < 4; ++j) { const int n = (lane >> 3) + 8 * j; const LAS float* s = scr + (8 * c) * 33 + n;
        v4u o; o.x = pk2(s[0 * 33], s[1 * 33]); o.y = pk2(s[2 * 33], s[3 * 33]); o.z = pk2(s[4 * 33], s[5 * 33]); o.w = pk2(s[6 * 33], s[7 * 33]);
        *(GAS v4u*)(WT + (size_t)(n0 + n) * K + k0 + 8 * c) = o; }
    LDS_WAIT(); asm volatile("" ::: "memory");
}
template <bool OUTBF>
__device__ __forceinline__ void rms_row(const float* xrow, const float* gain, void* orow, int lane) {
    const GAS f32x4* xr = (const GAS f32x4*)xrow + lane; const GAS f32x4* gr = (const GAS f32x4*)gain + lane;
    f32x4 v[16]; float s = 0.f;
#pragma unroll
    for (int j = 0; j < 16; ++j) { v[j] = xr[64 * j]; s += (v[j].x * v[j].x + v[j].y * v[j].y) + (v[j].z * v[j].z + v[j].w * v[j].w); }
    const float rs = 1.0f / sqrtf(wave_sum(s) * (1.f / D) + NORM_EPS);
#pragma unroll
    for (int j = 0; j < 16; ++j) { const f32x4 g = gr[64 * j]; const f32x4 o = v[j] * rs * g;
        if (OUTBF) ((GAS unsigned long long*)orow)[lane + 64 * j] = (unsigned long long)pk2(o.x, o.y) | ((unsigned long long)pk2(o.z, o.w) << 32);
        else ((GAS f32x4*)orow)[lane + 64 * j] = o; }
}
__device__ __forceinline__ void p0_prologue(Frame& F) {
    LAS float* scr = (LAS float*)(F.lds + RING_OFF + F.wave * 16384);
    const int gw = F.vcu * NWAVES + F.wave, NGW = F.G * NWAVES;
    constexpr int I_IN = (D / 64) * (INW / 32), I_AT = (AW / 64) * (D / 32), I_RN = (DR / 64) * (D / 32), I_OUT = (D / 64) * (D / 32), I_UP = (D / 64) * (FF / 32), I_DN = (FF / 64) * (D / 32);
    constexpr int NITEMS = I_IN + I_AT + I_RN + I_OUT + I_UP + I_DN;
    unsigned char* ws = F.ws;
    for (int it = gw; it < NITEMS; it += NGW) {
        int r = it;
        if (r < I_IN) { p0_transpose_item(F.in[3], D, INW, (bf16*)(ws + WS_WIN), scr, r, F.lane); continue; } r -= I_IN;
        if (r < I_AT) { p0_transpose_item(F.in[13], AW, D, (bf16*)(ws + WS_WATT), scr, r, F.lane); continue; } r -= I_AT;
        if (r < I_RN) { p0_transpose_item(F.in[14], DR, D, (bf16*)(ws + WS_WRNN), scr, r, F.lane); continue; } r -= I_RN;
        if (r < I_OUT) { p0_transpose_item(F.in[16], D, D, (bf16*)(ws + WS_WOUT), scr, r, F.lane); continue; } r -= I_OUT;
        if (r < I_UP) { p0_transpose_item(F.in[18], D, FF, (bf16*)(ws + WS_WUP), scr, r, F.lane); continue; } r -= I_UP;
        p0_transpose_item(F.in[19], FF, D, (bf16*)(ws + WS_WDN), scr, r, F.lane);
    }
    for (int e = gw * 64 + F.lane; e < 2 * LRU_NB * NWAVES * 2 * 4 * 64; e += NGW * 64) {
        const int ln = e & 63, ks = (e >> 6) & 3, g = (e >> 8) & 1, wv = (e >> 9) & 7, n = (e >> 12) & 15, z = e >> 16;
        const float* wp = (g ? F.in[10] : F.in[8]) + (size_t)((z * LRU_NB + n) * LRU_BW + 32 * ks + 8 * (ln >> 4)) * LRU_BW + 16 * wv + (ln & 15);
        v4u o; o.x = pk2(wp[0 * LRU_BW], wp[1 * LRU_BW]); o.y = pk2(wp[2 * LRU_BW], wp[3 * LRU_BW]); o.z = pk2(wp[4 * LRU_BW], wp[5 * LRU_BW]); o.w = pk2(wp[6 * LRU_BW], wp[7 * LRU_BW]);
        *(GAS v4u*)(ws + WS_WF + (size_t)e * 16) = o; }
    for (int m = gw; m < NTOK; m += NGW) rms_row<true>(xrow_ptr(F, m), F.in[2], (bf16*)(ws + WS_H1) + (size_t)m * D, F.lane);
}
typedef unsigned short u16;
__device__ __forceinline__ float bf2f(unsigned short b) { return __uint_as_float((unsigned)b << 16); }
__device__ __forceinline__ float bflo(unsigned w) { return __uint_as_float(w << 16); }
__device__ __forceinline__ float bfhi(unsigned w) { return __uint_as_float(w & 0xffff0000u); }
__device__ __forceinline__ float sigm(float x) { return __builtin_amdgcn_rcpf(1.0f + __builtin_amdgcn_exp2f(-1.4426950408889634f * x)); }
__device__ __forceinline__ int seq_pos(int tok) { return tok < NTOK_P ? (tok & (SEQ_P - 1)) : tok - NTOK_P; }

__device__ __forceinline__ void qk_norm_rope(Frame& F, bf16* Q, bf16* K) {
    const int gw = F.vcu * NWAVES + F.wave, NGW = F.G * NWAVES, lane = F.lane, c16 = lane & 15;
    float inv[4];
#pragma unroll
    for (int j = 0; j < 4; ++j) { const int pi = (4 * c16 + j) & 31; inv[j] = __builtin_amdgcn_exp2f(-(float)pi * (13.287712379549449f / 32.0f)); }
    float gq[8], gk[8];
#pragma unroll
    for (int e = 0; e < 8; ++e) { gq[e] = F.in[4][8 * c16 + e]; gk[e] = F.in[5][8 * c16 + e]; }
    for (int it = gw; it < NTOK * 5; it += NGW) {
        const int tok = it / 5, g = it % 5;
        bf16* p = (g < 4 ? Q + (size_t)tok * AW + g * 512 : K + (size_t)tok * KVW) + (lane >> 4) * HD + 8 * c16;
        const v4u w = *(const GAS v4u*)p;
        float x[8] = {bflo(w.x), bfhi(w.x), bflo(w.y), bfhi(w.y), bflo(w.z), bfhi(w.z), bflo(w.w), bfhi(w.w)};
        float s = 0.f;
#pragma unroll
        for (int e = 0; e < 8; ++e) s += x[e] * x[e];
        s += __shfl_xor(s, 1); s += __shfl_xor(s, 2); s += __shfl_xor(s, 4); s += __shfl_xor(s, 8);
        const float rs = 1.0f / sqrtf(s * (1.0f / HD) + NORM_EPS);
        const int pos = seq_pos(tok); const float pf = (float)(c16 < 8 ? (pos >> 6) : (pos & 63));
        float y[8];
#pragma unroll
        for (int j = 0; j < 4; ++j) { const float ang = pf * inv[j]; const float cs = cosf(ang), sn = sinf(ang);
            const float a = x[2 * j] * rs * (g < 4 ? gq[2 * j] : gk[2 * j]), b = x[2 * j + 1] * rs * (g < 4 ? gq[2 * j + 1] : gk[2 * j + 1]);
            y[2 * j] = a * cs - b * sn; y[2 * j + 1] = a * sn + b * cs; }
        v4u o; o.x = pk2(y[0], y[1]); o.y = pk2(y[2], y[3]); o.z = pk2(y[4], y[5]); o.w = pk2(y[6], y[7]);
        *(GAS v4u*)p = o;
    }
}

constexpr int LROW = 272;
constexpr int L_XC = 0, L_YT = 36864;
template <int DIR, bool FINAL>
__device__ __forceinline__ void lru_dir(LAS unsigned char* lds, const pg8::bf16x8* wf  , pg8::f32x4 (&hf)[8], float ba, float bi, float sp, float cin,
                                        int lane, int chl, float* aggP, float* aggH) {
    using pg8::f32x4; using pg8::bf16x8;
    const int fr = lane & 15, quad = lane >> 4;
    bf16x8 Bf[2][4];
#pragma unroll
    for (int g = 0; g < 2; ++g)
#pragma unroll
        for (int ks = 0; ks < 4; ++ks) Bf[g][ks] = wf[(g * 4 + ks) * 64 + lane];
    f32x4 accR[8], accI[8];
#pragma unroll
    for (int m = 0; m < 8; ++m) { accR[m] = (f32x4){0.f, 0.f, 0.f, 0.f}; accI[m] = (f32x4){0.f, 0.f, 0.f, 0.f}; }
    const int arow = 32 * (fr >> 2) + (fr & 3);
#pragma unroll
    for (int m = 0; m < 8; ++m)
#pragma unroll
        for (int ks = 0; ks < 4; ++ks) {
            const bf16x8 a = *(const LAS bf16x8*)(lds + L_XC + (arow + 4 * m) * LROW + (32 * ks + 8 * quad) * 2);
            accR[m] = __builtin_amdgcn_mfma_f32_16x16x32_bf16(a, Bf[0][ks], accR[m], 0, 0, 0);
            accI[m] = __builtin_amdgcn_mfma_f32_16x16x32_bf16(a, Bf[1][ks], accI[m], 0, 0, 0);
            if (ks == 3 && (m & 1)) __builtin_amdgcn_sched_barrier(0);
        }
    float cp = 1.f, hl = 0.f;
#pragma unroll
    for (int mm = 0; mm < 8; ++mm)
#pragma unroll
        for (int rr = 0; rr < 4; ++rr) {
            const int m = DIR ? 7 - mm : mm, r = DIR ? 3 - rr : rr;
            const int tau = 32 * quad + 4 * m + r;
            const float xv = bf2f(*(const LAS u16*)(lds + L_XC + tau * LROW + chl * 2));
            const float rg = sigm(accR[m][r] + ba), ig = sigm(accI[m][r] + bi);
            const float la = -8.0f * rg * sp;
            const float a = __builtin_amdgcn_exp2f(1.4426950408889634f * la);
            const float t = 2.0f * la;
            const float om = t > -0.1f ? -t * (1.0f + t * (0.5f + t * (0.16666667f + t * (0.041666668f + t * 0.0083333333f)))) : 1.0f - __builtin_amdgcn_exp2f(1.4426950408889634f * t);
            const float u = sqrtf(om) * (ig * xv);
            cp = cp * a; hl = a * hl + u;
            accR[m][r] = cp; accI[m][r] = hl;
            if (rr == 3) __builtin_amdgcn_sched_barrier(0);
        }
    float Pq[4], Hq[4];
#pragma unroll
    for (int q = 0; q < 4; ++q) { Pq[q] = __shfl(cp, fr + 16 * q); Hq[q] = __shfl(hl, fr + 16 * q); }
    float cm;
    if (DIR == 0) { const float c1 = Pq[0] * cin + Hq[0], c2 = Pq[1] * c1 + Hq[1], c3 = Pq[2] * c2 + Hq[2], c4 = Pq[3] * c3 + Hq[3];
        cm = quad == 0 ? cin : quad == 1 ? c1 : quad == 2 ? c2 : c3; *aggH = c4; }
    else { const float d2 = Pq[3] * cin + Hq[3], d1 = Pq[2] * d2 + Hq[2], d0 = Pq[1] * d1 + Hq[1], de = Pq[0] * d0 + Hq[0];
        cm = quad == 3 ? cin : quad == 2 ? d2 : quad == 1 ? d1 : d0; *aggH = de; }
    *aggP = (Pq[0] * Pq[1]) * (Pq[2] * Pq[3]);
    if (FINAL) {
#pragma unroll
        for (int m = 0; m < 8; ++m) { const f32x4 h = accI[m] + accR[m] * cm; hf[m] = DIR == 0 ? h : hf[m] + h; }
    }
}
template <bool FINAL>
__device__ __forceinline__ void lru_phase(Frame& F, const bf16* XR, const bf16* YR, bf16* REC) {
    using pg8::f32x4; using pg8::bf16x8;
    LAS unsigned char* lds = F.lds + RING_OFF;
    const int w = F.wave;
    float* AGG = (float*)(F.ws + WS_AGG); const float* CARRY = (const float*)(F.ws + WS_CARRY);
    const bf16x8* WF = (const bf16x8*)(F.ws + WS_WF); float ba[2], bi[2], sp[2]; int cur_n = -1;
    for (int L = blockIdx.x; L < NCHUNK * LRU_NB; L += F.G) {
        const int chunk = L / LRU_NB, n = L % LRU_NB, t0 = chunk * LCH;
        int tid = F.tid; asm volatile("" : "+v"(tid));
        const int lane = tid & 63, fr = lane & 15, quad = lane >> 4, chl = 16 * w + fr;
        const int cg = tid & 15, tg = tid >> 4;
        if (n != cur_n) {
            cur_n = n;
#pragma unroll
            for (int z = 0; z < 2; ++z) { const int ch = z * DR + n * LRU_BW + chl; ba[z] = F.in[9][ch]; bi[z] = F.in[11][ch]; sp[z] = log1pf(expf(-F.in[12][ch])); }
        }
        __syncthreads();
        {
            const int ch0 = n * LRU_BW + 8 * cg; const int p0 = seq_pos(t0), slen = t0 < NTOK_P ? SEQ_P : SEQ_S;
            float cw[4][8], cb[8];
#pragma unroll
            for (int j = 0; j < 4; ++j)
#pragma unroll
                for (int e = 0; e < 8; ++e) cw[j][e] = F.in[6][j * DR + ch0 + e];
#pragma unroll
            for (int e = 0; e < 8; ++e) cb[e] = F.in[7][ch0 + e];
            v4u xin[7];
#pragma unroll
            for (int i = 0; i < 7; ++i) { const int lt = 4 * tg - 1 + i, p = p0 + lt;
                xin[i] = (p >= 0 && p < slen) ? *(const GAS v4u*)(XR + (size_t)(t0 + lt) * DR + ch0) : (v4u){0u, 0u, 0u, 0u}; }
#pragma unroll
            for (int k = 0; k < 4; ++k) { float o[8];
#pragma unroll
                for (int e = 0; e < 8; ++e) o[e] = cb[e];
#pragma unroll
                for (int j = 0; j < 4; ++j) { const v4u v = xin[k + j]; const float xv[8] = {bflo(v.x), bfhi(v.x), bflo(v.y), bfhi(v.y), bflo(v.z), bfhi(v.z), bflo(v.w), bfhi(v.w)};
#pragma unroll
                    for (int e = 0; e < 8; ++e) o[e] += cw[j][e] * xv[e]; }
                v4u pk; pk.x = pk2(o[0], o[1]); pk.y = pk2(o[2], o[3]); pk.z = pk2(o[4], o[5]); pk.w = pk2(o[6], o[7]);
                *(LAS v4u*)(lds + L_XC + (4 * tg + k) * LROW + cg * 16) = pk; }
            if (FINAL) {
#pragma unroll
                for (int k = 0; k < 4; ++k) *(LAS v4u*)(lds + L_YT + (4 * tg + k) * LROW + cg * 16) = *(const GAS v4u*)(YR + (size_t)(t0 + 4 * tg + k) * DR + ch0); }
        }
        float cinf = 0.f, cinb = 0.f;
        if (FINAL) { cinf = CARRY[((size_t)chunk * 2 + 0) * DR + n * LRU_BW + chl]; cinb = CARRY[((size_t)chunk * 2 + 1) * DR + n * LRU_BW + chl]; }
        __syncthreads();
        f32x4 hf[8]; float aP, aH;
        lru_dir<0, FINAL>(lds, WF + (size_t)((0 * LRU_NB + n) * NWAVES + w) * 512, hf, ba[0], bi[0], sp[0], cinf, lane, chl, &aP, &aH);
        if (!FINAL && quad == 0) { float* ag = AGG + (size_t)chunk * 4 * DR + n * LRU_BW + chl; ag[0] = aP; ag[DR] = aH; }
        lru_dir<1, FINAL>(lds, WF + (size_t)((1 * LRU_NB + n) * NWAVES + w) * 512, hf, ba[1], bi[1], sp[1], cinb, lane, chl, &aP, &aH);
        if (!FINAL && quad == 0) { float* ag = AGG + (size_t)chunk * 4 * DR + n * LRU_BW + chl; ag[2 * DR] = aP; ag[3 * DR] = aH; }
        if (FINAL) {
#pragma unroll
            for (int m = 0; m < 8; ++m)
#pragma unroll
                for (int r = 0; r < 4; ++r) { const int tau = 32 * quad + 4 * m + r; LAS u16* yp = (LAS u16*)(lds + L_YT + tau * LROW + chl * 2);
                    const float y = bf2f(*yp); const float ge = y * sigm(1.5957691216057308f * (y + 0.044715f * y * y * y));
                    *yp = (u16)f2bf(hf[m][r] * ge); if (r == 3) __builtin_amdgcn_sched_barrier(0); }
            __syncthreads();
#pragma unroll
            for (int k = 0; k < 4; ++k) *(GAS v4u*)(REC + (size_t)(t0 + 4 * tg + k) * DR + n * LRU_BW + 8 * cg) = *(const LAS v4u*)(lds + L_YT + (4 * tg + k) * LROW + cg * 16);
        }
    }
    __syncthreads();
}
__device__ __forceinline__ void lru_carry(Frame& F) {
    const float* AGG = (const float*)(F.ws + WS_AGG); float* CARRY = (float*)(F.ws + WS_CARRY);
    const int per = (5 * 2 * DR + F.G - 1) / F.G;
    if (F.tid < per) {
        const int id = F.vcu * per + F.tid;
        if (id < 5 * 2 * DR) {
            const int s = id / (2 * DR), dir = (id / DR) & 1, ch = id % DR;
            const int c0 = s < 4 ? 32 * s : 128, nc = s < 4 ? 32 : 64;
            float h = 0.f;
            if (dir == 0) {
#pragma unroll 8
                for (int c = c0; c < c0 + nc; ++c) { const float P = AGG[((size_t)c * 4 + 0) * DR + ch], H = AGG[((size_t)c * 4 + 1) * DR + ch]; CARRY[((size_t)c * 2 + 0) * DR + ch] = h; h = P * h + H; }
            } else {
#pragma unroll 8
                for (int c = c0 + nc - 1; c >= c0; --c) { const float P = AGG[((size_t)c * 4 + 2) * DR + ch], H = AGG[((size_t)c * 4 + 3) * DR + ch]; CARRY[((size_t)c * 2 + 1) * DR + ch] = h; h = P * h + H; }
            }
        }
    }
}
__device__ __forceinline__ void attn_phase_all(Frame& F, char* lds, const bf16* Q, const bf16* K, const bf16* V, bf16* O) {
    for (int L = blockIdx.x; L < 1536; L += F.G) {
        const int c = L & 255, i = L >> 8, xcd = c & 7, rank = c >> 3;
        int row0, head, kvh, qb, seq;
        if (i < 2) { const int idx = i * 32 + rank, grp = xcd >> 1, u = (xcd & 1) * 64 + idx; kvh = grp; head = grp * 4 + (u >> 5); qb = u & 31; row0 = NTOK_P; seq = SEQ_S; }
        else { const int idx = (i - 2) * 32 + rank, grp = 2 * xcd + (idx >> 6), v = idx & 63, b = grp >> 2; kvh = grp & 3; head = kvh * 4 + (v >> 4); qb = v & 15; row0 = b * SEQ_P; seq = SEQ_P; }
        attn::attn_dense_body(Q + (size_t)(row0 + qb * 256) * AW + head * HD, K + (size_t)row0 * KVW + kvh * HD, V + (size_t)row0 * KVW + kvh * HD,
                              O + (size_t)(row0 + qb * 256) * AW + head * HD, seq, lds);
    }
}
constexpr int NPH = 13;
struct Args { const float* in[21]; float* out; unsigned char* ws; int ph_lo, ph_hi; };
__global__ void __launch_bounds__(NWAVES * 64, 2) mk_fwd(Args args) {
    extern __shared__ __attribute__((aligned(16))) unsigned char lds[];
    Frame F;
    F.lds = (LAS unsigned char*)lds;
    F.MISC = (volatile LAS unsigned*)(F.lds + MISC_OFF);
    F.tid = threadIdx.x; F.lane = F.tid & 63; F.wave = __builtin_amdgcn_readfirstlane(F.tid >> 6);
    F.G = gridDim.x; { const int bx = blockIdx.x; F.vcu = (F.G % 8 == 0) ? (bx % 8) * (F.G / 8) + bx / 8 : bx; }
    unsigned char* ws = args.ws; F.ws = ws; F.out = args.out;
#pragma unroll
    for (int i = 0; i < 21; ++i) F.in[i] = args.in[i];
    F.ctl = (gu32*)(ws + WS_CTL);
    for (int u = F.tid; u < (LDS_BYTES - LDSCTL_OFF) / 4; u += NWAVES * 64) ((LAS unsigned*)(F.lds + LDSCTL_OFF))[u] = 0u;
    __syncthreads();
    XcdBarrier bar; bar.bar = (unsigned*)(F.ctl + CW_BAR); bar.x = 0; bar.st = nullptr;
    if (!MK_PER_PHASE) bar = xcd_barrier_post((unsigned*)(F.ctl + CW_BAR), F.MISC + 8);
    const int lo = args.ph_lo, hi = args.ph_hi;
#define IN(k) (lo <= (k) && (k) < hi)
#define SEAM(k) do { if (IN(k) && IN((k) + 1)) xcd_barrier(bar); } while (0)
    const int gw = F.vcu * NWAVES + F.wave, NGW = F.G * NWAVES;
    bf16* const W_IN = (bf16*)(ws + WS_WIN); bf16* const W_ATT = (bf16*)(ws + WS_WATT); bf16* const W_RNN = (bf16*)(ws + WS_WRNN); bf16* const W_OUT = (bf16*)(ws + WS_WOUT);
    bf16* const W_UP = (bf16*)(ws + WS_WUP); bf16* const W_DN = (bf16*)(ws + WS_WDN);
    bf16* const H1 = (bf16*)(ws + WS_H1); bf16* const ATT = (bf16*)(ws + WS_ATT); bf16* const REC = (bf16*)(ws + WS_REC); bf16* const HM = (bf16*)(ws + WS_HM);
    bf16* const QB = (bf16*)(ws + WS_Q); bf16* const KB = (bf16*)(ws + WS_K); bf16* const VB = (bf16*)(ws + WS_V); bf16* const XR = (bf16*)(ws + WS_XR); bf16* const YR = (bf16*)(ws + WS_YR);
    bf16* const MRG = (bf16*)(ws + WS_MRG); bf16* const HID = (bf16*)(ws + WS_HID); bf16* const T1 = (bf16*)(ws + WS_T1);
    bf16* const G0 = (bf16*)F.out; bf16* const G1 = (bf16*)F.out + (size_t)NTOK * D;

    if (IN(0)) { p0_prologue(F); }
    SEAM(0);
#if MK_STAGE >= 9
    if (IN(1)) {
        pg8::Gemm g{H1, W_IN, NTOK, INW, D}; pg8::StaticOrder S; S.init(NTOK, INW, F.G, (int)blockIdx.x);
        pg8::EpiZ E{QB, KB, VB, XR, YR, G0, G1, F.in[15]};
        pg8::gemm_phase<pg8::EpiZ, pg8::StaticOrder, true, true>(F.lds + RING_OFF, g, S, E);
    }
    SEAM(1);
    if (IN(2)) {
#ifndef NO_ROPE
        qk_norm_rope(F, QB, KB);
#endif
#ifndef NO_LRU1
        lru_phase<false>(F, XR, YR, nullptr);
#endif
    }
    SEAM(2);
    if (IN(3)) { lru_carry(F);
#ifndef NO_ATTN
        attn_phase_all(F, (char*)lds + RING_OFF, QB, KB, VB, ATT);
#endif
    }
    SEAM(3);
    if (IN(4)) {
#ifndef NO_LRU3
        lru_phase<true>(F, XR, YR, REC);
#endif
        __syncthreads();
        pg8::Gemm g{ATT, W_ATT, NTOK, D, AW}; pg8::StaticOrder S; S.init(NTOK, D, F.G, (int)blockIdx.x);
        pg8::EpiGate E{T1, G0, nullptr, D};
        pg8::gemm_phase<pg8::EpiGate, pg8::StaticOrder, true, true>(F.lds + RING_OFF, g, S, E);
    }
    SEAM(4);
    if (IN(5)) {
        pg8::Gemm g{REC, W_RNN, NTOK, D, DR}; pg8::StaticOrder S; S.init(NTOK, D, F.G, (int)blockIdx.x);
        pg8::EpiGate E{MRG, G1, T1, D};
        pg8::gemm_phase<pg8::EpiGate, pg8::StaticOrder, true, true>(F.lds + RING_OFF, g, S, E);
    }
    SEAM(5);
    if (IN(6)) {
        pg8::Gemm g{MRG, W_OUT, NTOK, D, D}; pg8::StaticOrder S; S.init(NTOK, D, F.G, (int)blockIdx.x);
        pg8::EpiResF32 E{F.in[0], F.in[1], NTOK_P, F.out, D};
        pg8::gemm_phase<pg8::EpiResF32, pg8::StaticOrder, true, true>(F.lds + RING_OFF, g, S, E);
    }
    SEAM(6);
#else
    if (IN(6)) { for (int m = gw; m < NTOK; m += NGW) { const GAS f32x4* s = (const GAS f32x4*)xrow_ptr(F, m) + F.lane; GAS f32x4* d = (GAS f32x4*)(F.out + (size_t)m * D) + F.lane;
#pragma unroll
            for (int j = 0; j < 16; ++j) d[64 * j] = s[64 * j]; } }
    SEAM(1); SEAM(2); SEAM(3); SEAM(4); SEAM(5); SEAM(6);
#endif
    if (IN(7)) { for (int m = gw; m < NTOK; m += NGW) rms_row<true>(F.out + (size_t)m * D, F.in[17], HM + (size_t)m * D, F.lane); }
    SEAM(7);
#define MLP_UP(c) do { pg8::Gemm g{HM + (size_t)(c) * MLP_ROWS * D, W_UP, MLP_ROWS, FF, D}; pg8::StaticOrder S; S.init(MLP_ROWS, FF, F.G, (int)blockIdx.x); \
        pg8::EpiRelu2 E{HID, FF}; pg8::gemm_phase<pg8::EpiRelu2, pg8::StaticOrder, true, true>(F.lds + RING_OFF, g, S, E); } while (0)
#define MLP_DN(c) do { pg8::Gemm g{HID, W_DN, MLP_ROWS, D, FF}; pg8::StaticOrder S; S.init(MLP_ROWS, D, F.G, (int)blockIdx.x); float* o = F.out + (size_t)(c) * MLP_ROWS * D; \
        pg8::EpiResF32 E{o, o, MLP_ROWS, o, D}; pg8::gemm_phase<pg8::EpiResF32, pg8::StaticOrder, true, true>(F.lds + RING_OFF, g, S, E); } while (0)
    if (IN(8)) MLP_UP(0);
    SEAM(8);
    if (IN(9)) MLP_DN(0);
    SEAM(9);
    if (IN(10)) MLP_UP(1);
    SEAM(10);
    if (IN(11)) MLP_DN(1);
    SEAM(11);
    if (IN(12)) { for (int m = gw; m < NTOK; m += NGW) rms_row<false>(F.out + (size_t)m * D, F.in[20], F.out + (size_t)m * D, F.lane); }
#undef IN
#undef SEAM
}

extern "C" void kernel_launch(void* const* d_in, const int* in_sizes, int n_in, void* d_out, int out_size, void* d_ws, size_t ws_size, hipStream_t stream) {
    static int grid = 0;
    if (grid == 0) {
        if (n_in != 21 || in_sizes[0] != NTOK_P * D || in_sizes[1] != NTOK_S * D || out_size != NTOK * D || ws_size < WS_END) {
            fprintf(stderr, "kernel_launch: shape / workspace mismatch (n_in %d, out %d, ws %zu, need %zu); nothing launched\n", n_in, out_size, ws_size, (size_t)WS_END); grid = -1; return; }
        int dev = 0, cus = 0, per_cu = 0;
        if (hipGetDevice(&dev) != hipSuccess || hipDeviceGetAttribute(&cus, hipDeviceAttributeMultiprocessorCount, dev) != hipSuccess) { grid = -1; return; }
        if (hipFuncSetAttribute((const void*)mk_fwd, hipFuncAttributeMaxDynamicSharedMemorySize, LDS_BYTES) != hipSuccess) { fprintf(stderr, "kernel_launch: hipFuncSetAttribute failed\n"); grid = -1; return; }
        if (hipOccupancyMaxActiveBlocksPerMultiprocessor(&per_cu, (const void*)mk_fwd, NWAVES * 64, LDS_BYTES) != hipSuccess || per_cu < 1) { fprintf(stderr, "kernel_launch: occupancy query says %d blocks per CU\n", per_cu); grid = -1; return; }
        (void)hipGetLastError();
        grid = cus;
    }
    if (grid < 0) return;
    if (hipMemsetAsync((char*)d_ws + WS_CTL, 0, CTL_ZERO_BYTES, stream) != hipSuccess) return;
    Args a{};
    for (int i = 0; i < 21; ++i) a.in[i] = (const float*)d_in[i];
    a.out = (float*)d_out; a.ws = (unsigned char*)d_ws;
#if MK_PER_PHASE
    for (int p = 0; p < NPH; ++p) { a.ph_lo = p; a.ph_hi = p + 1; hipLaunchKernelGGL(mk_fwd, dim3(grid), dim3(NWAVES * 64), LDS_BYTES, stream, a); }
#else
    a.ph_lo = 0; a.ph_hi = NPH; hipLaunchKernelGGL(mk_fwd, dim3(grid), dim3(NWAVES * 64), LDS_BYTES, stream, a);
#endif
    const hipError_t le = hipPeekAtLastError();
    if (le != hipSuccess) fprintf(stderr, "kernel_launch: launch failed: %s\n", hipGetErrorName(le));
}
```

```cpp
#define ORD_DN pg8::StaticOrder
#define ORD_UP pg8::SharedOrder
#include <hip/hip_runtime.h>
#include <hip/hip_bf16.h>
#include <cstdio>
#include <cstdint>
namespace pg8 {
#define PG8_LAS __attribute__((address_space(3)))
typedef unsigned short bf16_t;
typedef short bf16x8 __attribute__((ext_vector_type(8)));
typedef float f32x4 __attribute__((ext_vector_type(4)));
typedef unsigned u32x4 __attribute__((ext_vector_type(4)));
constexpr int BM = 256, BK = 64, HALF = 128, HTB = HALF * BK * 2  , STAGE_BYTES = 8 * HTB, NXCD = 8, WGM = 8;

__host__ __device__ __forceinline__ int lds_byte(int r, int c) { const int st = (r >> 4) * 2 + (c >> 5), rr = r & 15, cc = c & 31, ob = rr * 64 + cc * 2; return st * 1024 + (ob ^ (((ob >> 9) & 1) << 5)); }
__host__ __device__ __forceinline__ void stage_rc(int b, int& R, int& C) { const int st = b / 1024, sb = b % 1024, swz = sb ^ (((sb >> 9) & 1) << 5); R = (st >> 1) * 16 + swz / 64; C = (st & 1) * 32 + (swz % 64) / 2; }
__host__ __device__ __forceinline__ int perm32(int rho) { const int n = rho >> 4, i = rho & 15; return 8 * (i >> 2) + 4 * n + (i & 3); }

#ifndef PG8_TILED
#define PG8_TILED 1
#endif
__host__ __device__ __forceinline__ size_t toff(int row, int col, int Kd) {
#if PG8_TILED
    return ((size_t)((row >> 8) * (Kd >> 6) + (col >> 6)) << 14) + (size_t)(((row & 255) << 6) + (col & 63));
#else
    return (size_t)row * Kd + col;
#endif
}
struct Unit { int pm, pn; };
struct Gemm { const bf16_t* A; const bf16_t* Bt; int M, N, K; };

struct StaticOrder {
    int nM, nN, nwg, G, c, wgm;
    __host__ __device__ void init(int M, int N, int G_, int c_, int wgm_ = WGM) { nM = M / BM; nN = N / BM; nwg = nM * nN; G = G_; c = c_; wgm = wgm_; }
    __host__ __device__ bool next(int i, Unit& u) const { const long L = (long)i * G + c; if (L >= nwg) return false; map((int)L, u); return true; }
    __host__ __device__ void map(int L, Unit& u) const {
        int wgid = L; { const int q = nwg / NXCD, r = nwg % NXCD, xcd = wgid % NXCD, off = wgid / NXCD; wgid = (xcd < r ? xcd * (q + 1) : r * (q + 1) + (xcd - r) * q) + off; }
        const int nig = wgm * nN, gid = wgid / nig, fm = gid * wgm, gsz = (nM - fm) < wgm ? (nM - fm) : wgm;
        u.pm = fm + ((wgid % nig) % gsz); u.pn = (wgid % nig) / gsz;
    }
    __device__ __forceinline__ void a_ready(const Unit&) const {}
    __device__ __forceinline__ void done(const Unit&) const {}
};

__device__ __forceinline__ unsigned cvt_pk_bf16(float lo, float hi) { unsigned r; asm volatile("v_cvt_pk_bf16_f32 %0, %1, %2" : "=v"(r) : "v"(lo), "v"(hi)); return r; }
typedef float f32x2 __attribute__((ext_vector_type(2)));
__device__ __forceinline__ f32x2 gelu_pk(f32x2 v) {
    const f32x2 av = __builtin_elementwise_abs(v), d = av * 0.2316418882f + 1.0f;
    f32x2 t; t.x = __builtin_amdgcn_rcpf(d.x); t.y = __builtin_amdgcn_rcpf(d.y);
    f32x2 q = t * 0.5307027145f + (-0.7265760135f); q = q * t + 0.7107068705f; q = q * t + (-0.142248368f); q = q * t + 0.127414796f; q = q * t;
    const f32x2 s = (v * v) * (-0.72134752044f);
    f32x2 e; e.x = __builtin_amdgcn_exp2f(s.x); e.y = __builtin_amdgcn_exp2f(s.y);
    const f32x2 m = v * (q * e), r = v - m;
    f32x2 o; o.x = v.x < 0.f ? m.x : r.x; o.y = v.y < 0.f ? m.y : r.y; return o;
}

#ifdef EPI_NT
#define EPI_ST16(p, v) __builtin_nontemporal_store((v), (p))
#else
#define EPI_ST16(p, v) (*(p) = (v))
#endif
#ifndef DN_AB
#define DN_AB 1
#endif
#ifndef MID_MB
#define MID_MB 2
#endif
#ifndef EPI_MB
#define EPI_MB 4
#endif
__device__ __forceinline__ float bf_lo(unsigned w) { return __uint_as_float(w << 16); }
__device__ __forceinline__ float bf_hi(unsigned w) { return __uint_as_float(w & 0xffff0000u); }
__device__ __forceinline__ float sigmoid_f(float x) { return __builtin_amdgcn_rcpf(1.0f + __builtin_amdgcn_exp2f(-1.4426950408889634f * x)); }

struct EpiZ {
    static constexpr bool PERM = true, AFTER_DRAIN = false, MID = false;
    bf16_t *Q, *Kb, *V, *XR, *YR; unsigned char *G0, *G1; const float* b_gate;
    __device__ __forceinline__ void operator()(const f32x4 (&acc)[2][2][4][2], const Unit& u, int wr, int wc, int fr, int fq) const {
        asm volatile("" : "+v"(fr), "+v"(fq));
        const int pn = u.pn; bf16_t* base; unsigned char* gb = nullptr; int ldc, colt; const float* bias = nullptr;
        if (pn < 8)       { base = Q;  ldc = 2048; colt = pn * BM; }
        else if (pn < 10) { base = Kb; ldc = 512;  colt = (pn - 8) * BM; }
        else if (pn < 12) { base = V;  ldc = 512;  colt = (pn - 10) * BM; }
        else if (pn < 20) { base = XR; ldc = 2048; colt = (pn - 12) * BM; }
        else if (pn < 28) { base = YR; ldc = 2048; colt = (pn - 20) * BM; }
        else if (pn < 44) { base = Q; gb = G0; ldc = 4096; colt = (pn - 28) * BM; bias = b_gate + colt; }
        else              { base = Q; gb = G1; ldc = 4096; colt = (pn - 44) * BM; bias = b_gate + 4096 + colt; }
        const int row0 = u.pm * BM + wr * 64 + fr, col0 = colt + wc * 32 + 8 * fq, bc0 = wc * 32 + 8 * fq;
        const bool gate = bias != nullptr;
        f32x4 bv[2][2];
#pragma unroll
        for (int bj = 0; bj < 2; ++bj)
#pragma unroll
            for (int n = 0; n < 2; ++n) bv[bj][n] = gate ? *(const f32x4*)(bias + bc0 + bj * HALF + 4 * n) : (f32x4){0.f, 0.f, 0.f, 0.f};
#pragma unroll
        for (int ai = 0; ai < 2; ++ai)
#pragma unroll
            for (int m = 0; m < 4; ++m) { bf16_t* rowp = base + (size_t)(row0 + ai * HALF + m * 16) * ldc + col0;
#pragma unroll
                for (int bj = 0; bj < 2; ++bj) { f32x4 v0 = acc[ai][bj][m][0], v1 = acc[ai][bj][m][1];
                    if (gate) { v0 = v0 + bv[bj][0]; v1 = v1 + bv[bj][1]; unsigned lo = 0u, hi = 0u;
#pragma unroll
                        for (int e = 0; e < 4; ++e) { lo |= (unsigned)(sigmoid_f(v0[e]) * 255.f + 0.5f) << (8 * e); hi |= (unsigned)(sigmoid_f(v1[e]) * 255.f + 0.5f) << (8 * e); }
                        typedef unsigned u32x2 __attribute__((ext_vector_type(2)));
                        *(u32x2*)(gb + (size_t)(row0 + ai * HALF + m * 16) * ldc + col0 + bj * HALF) = (u32x2){lo, hi}; continue; }
                    u32x4 w; w.x = cvt_pk_bf16(v0[0], v0[1]); w.y = cvt_pk_bf16(v0[2], v0[3]); w.z = cvt_pk_bf16(v1[0], v1[1]); w.w = cvt_pk_bf16(v1[2], v1[3]);
                    EPI_ST16((u32x4*)(rowp + bj * HALF), w); } }
    }
};

struct EpiMerge {
    struct MidState { unsigned g1[2][4][2][2]; };
    static __device__ __forceinline__ float gq(unsigned w, int e) { return fmaxf((float)((w >> (8 * e)) & 0xffu), 0.5f); }
    static constexpr bool PERM = true, AFTER_DRAIN = false, MID = true;
    bf16_t* O; const unsigned char* G0; const unsigned char* G1; int ldc;
    __device__ __forceinline__ void mid(f32x4 (&acc)[2][2][4][2], MidState& ms, const Unit& u, int wr, int wc, int fr, int fq) const {
        asm volatile("" : "+v"(fr), "+v"(fq));
        typedef unsigned u32x2 __attribute__((ext_vector_type(2)));
        const int row0 = u.pm * BM + wr * 64 + fr, col0 = u.pn * BM + wc * 32 + 8 * fq;
        u32x2 g[2][4][2];
#pragma unroll
        for (int ai = 0; ai < 2; ++ai)
#pragma unroll
            for (int m = 0; m < 4; ++m) { const size_t off = (size_t)(row0 + ai * HALF + m * 16) * ldc + col0;
#pragma unroll
                for (int bj = 0; bj < 2; ++bj) { g[ai][m][bj] = *(const u32x2*)(G0 + off + bj * HALF); const u32x2 h = *(const u32x2*)(G1 + off + bj * HALF); ms.g1[ai][m][bj][0] = h.x; ms.g1[ai][m][bj][1] = h.y; } }
#pragma unroll
        for (int ai = 0; ai < 2; ++ai)
#pragma unroll
            for (int m = 0; m < 4; ++m)
#pragma unroll
                for (int bj = 0; bj < 2; ++bj) { f32x4& v0 = acc[ai][bj][m][0]; f32x4& v1 = acc[ai][bj][m][1];
#pragma unroll
                    for (int e = 0; e < 4; ++e) { v0[e] *= gq(g[ai][m][bj].x, e) * __builtin_amdgcn_rcpf(gq(ms.g1[ai][m][bj][0], e)); v1[e] *= gq(g[ai][m][bj].y, e) * __builtin_amdgcn_rcpf(gq(ms.g1[ai][m][bj][1], e)); } }
    }
    __device__ __forceinline__ void operator()(const f32x4 (&acc)[2][2][4][2], const MidState& ms, const Unit& u, int wr, int wc, int fr, int fq) const {
        asm volatile("" : "+v"(fr), "+v"(fq));
        const int row0 = u.pm * BM + wr * 64 + fr, col0 = u.pn * BM + wc * 32 + 8 * fq;
#pragma unroll
        for (int ai = 0; ai < 2; ++ai)
#pragma unroll
            for (int m = 0; m < 4; ++m)
#pragma unroll
                for (int bj = 0; bj < 2; ++bj) { const f32x4 v0 = acc[ai][bj][m][0], v1 = acc[ai][bj][m][1]; const unsigned h0 = ms.g1[ai][m][bj][0], h1 = ms.g1[ai][m][bj][1]; constexpr float s = 1.0f / 255.0f; u32x4 w;
                    w.x = cvt_pk_bf16(gq(h0, 0) * s * v0[0], gq(h0, 1) * s * v0[1]); w.y = cvt_pk_bf16(gq(h0, 2) * s * v0[2], gq(h0, 3) * s * v0[3]);
                    w.z = cvt_pk_bf16(gq(h1, 0) * s * v1[0], gq(h1, 1) * s * v1[1]); w.w = cvt_pk_bf16(gq(h1, 2) * s * v1[2], gq(h1, 3) * s * v1[3]);
                    *(u32x4*)(O + toff(row0 + ai * HALF + m * 16, col0 + bj * HALF, ldc)) = w; }
    }
};

template <bool BASE_BF16, bool STORE_F32, bool STORE_BF16, bool RSCALE> struct EpiResF32 {
    static constexpr bool PERM = false, AFTER_DRAIN = false, MID = false;
    const float* B0; const float* B1; int split; float* out; int ldc; bf16_t* XB; float* rowsq; const float* rsq_in; float inv_k, eps; const bf16_t* BB;
    __device__ __forceinline__ void operator()(const f32x4 (&acc)[2][2][4][2], const Unit& u, int wr, int wc, int fr, int fq) const {
        asm volatile("" : "+v"(fr), "+v"(fq));
        const int rt0 = u.pm * BM; const float* bs = rt0 < split ? B0 + (size_t)rt0 * ldc : B1 + (size_t)(rt0 - split) * ldc; float* ob = out + (size_t)rt0 * ldc;
        const int col0 = u.pn * BM + wc * 32 + 4 * fq;
#pragma unroll
        for (int ai = 0; ai < 2; ++ai)
#pragma unroll
        for (int m0 = 0; m0 < 4; m0 += EPI_MB) {
            f32x4 b[4][2][2]; float sc[4];
#pragma unroll
            for (int m = m0; m < m0 + EPI_MB; ++m) sc[m] = RSCALE ? rsq_in[rt0 + wr * 64 + fr + ai * HALF + m * 16] : 0.f;
#pragma unroll
            for (int m = m0; m < m0 + EPI_MB; ++m) { const size_t off = (size_t)(wr * 64 + fr + ai * HALF + m * 16) * ldc + col0;
#pragma unroll
                for (int bj = 0; bj < 2; ++bj)
#pragma unroll
                    for (int n = 0; n < 2; ++n) {
                        if (BASE_BF16) { typedef unsigned u32x2 __attribute__((ext_vector_type(2))); const u32x2 w = *(const u32x2*)(BB + toff(rt0 + wr * 64 + fr + ai * HALF + m * 16, col0 + bj * HALF + n * 16, ldc));
                            b[m][bj][n] = (f32x4){bf_lo(w.x), bf_hi(w.x), bf_lo(w.y), bf_hi(w.y)}; }
                        else b[m][bj][n] = *(const f32x4*)(bs + off + bj * HALF + n * 16); } }
#pragma unroll
            for (int m = m0; m < m0 + EPI_MB; ++m) { const int rloc = wr * 64 + fr + ai * HALF + m * 16; const size_t off = (size_t)rloc * ldc + col0; float sq = 0.f; const float r2 = RSCALE ? __builtin_amdgcn_rcpf(sc[m] * inv_k + eps) : 1.0f;
#pragma unroll
                for (int bj = 0; bj < 2; ++bj)
#pragma unroll
                    for (int n = 0; n < 2; ++n) { const f32x4 o = b[m][bj][n] + acc[ai][bj][m][n] * r2; if (STORE_F32) *(f32x4*)(ob + off + bj * HALF + n * 16) = o;
                        sq += (o[0] * o[0] + o[1] * o[1]) + (o[2] * o[2] + o[3] * o[3]);
                        if (STORE_BF16) { typedef unsigned u32x2 __attribute__((ext_vector_type(2))); u32x2 w; w.x = cvt_pk_bf16(o[0], o[1]); w.y = cvt_pk_bf16(o[2], o[3]);
                            *(u32x2*)(XB + toff(rt0 + rloc, col0 + bj * HALF + n * 16, ldc)) = w; } }
                sq += __shfl_xor(sq, 16); sq += __shfl_xor(sq, 32);
#ifndef NO_ATOM
#ifdef MK_ATOM2
                if (fq == 0) { __hip_atomic_fetch_add(rowsq + rt0 + rloc, 0.5f * sq, __ATOMIC_RELAXED, __HIP_MEMORY_SCOPE_AGENT); __hip_atomic_fetch_add(rowsq + rt0 + rloc, 0.5f * sq, __ATOMIC_RELAXED, __HIP_MEMORY_SCOPE_AGENT); }
#else
                if (fq == 0) __hip_atomic_fetch_add(rowsq + rt0 + rloc, sq, __ATOMIC_RELAXED, __HIP_MEMORY_SCOPE_AGENT);
#endif
#endif
                }
        }
    }
};

struct EpiX1P {
    static constexpr bool PERM = true, AFTER_DRAIN = false, MID = false;
    const float* B0; const float* B1; int split; int ldc; bf16_t* XB; float* rowsq;
    __device__ __forceinline__ void operator()(const f32x4 (&acc)[2][2][4][2], const Unit& u, int wr, int wc, int fr, int fq) const {
        asm volatile("" : "+v"(fr), "+v"(fq));
        const int rt0 = u.pm * BM; const float* bs = rt0 < split ? B0 + (size_t)rt0 * ldc : B1 + (size_t)(rt0 - split) * ldc;
        const int col0 = u.pn * BM + wc * 32 + 8 * fq;
#pragma unroll
        for (int ai = 0; ai < 2; ++ai) {
            f32x4 b[4][2][2];
#pragma unroll
            for (int m = 0; m < 4; ++m) { const size_t off = (size_t)(wr * 64 + fr + ai * HALF + m * 16) * ldc + col0;
#pragma unroll
                for (int bj = 0; bj < 2; ++bj) { b[m][bj][0] = *(const f32x4*)(bs + off + bj * HALF); b[m][bj][1] = *(const f32x4*)(bs + off + bj * HALF + 4); } }
#pragma unroll
            for (int m = 0; m < 4; ++m) { const int rloc = wr * 64 + fr + ai * HALF + m * 16; float sq = 0.f;
#pragma unroll
                for (int bj = 0; bj < 2; ++bj) { const f32x4 o0 = b[m][bj][0] + acc[ai][bj][m][0], o1 = b[m][bj][1] + acc[ai][bj][m][1];
                    sq += ((o0[0] * o0[0] + o0[1] * o0[1]) + (o0[2] * o0[2] + o0[3] * o0[3])) + ((o1[0] * o1[0] + o1[1] * o1[1]) + (o1[2] * o1[2] + o1[3] * o1[3]));
                    u32x4 w; w.x = cvt_pk_bf16(o0[0], o0[1]); w.y = cvt_pk_bf16(o0[2], o0[3]); w.z = cvt_pk_bf16(o1[0], o1[1]); w.w = cvt_pk_bf16(o1[2], o1[3]);
                    *(u32x4*)(XB + toff(rt0 + rloc, col0 + bj * HALF, ldc)) = w; }
                sq += __shfl_xor(sq, 16); sq += __shfl_xor(sq, 32);
                if (fq == 0) __hip_atomic_fetch_add(rowsq + rt0 + rloc, sq, __ATOMIC_RELAXED, __HIP_MEMORY_SCOPE_AGENT); }
        }
    }
};
struct EpiDnP {
    static constexpr bool PERM = true, AFTER_DRAIN = false, MID = false;
    int ldc; bf16_t* XB; float* rowsq; const float* rsq_in; float inv_k, eps;
    __device__ __forceinline__ void operator()(const f32x4 (&acc)[2][2][4][2], const Unit& u, int wr, int wc, int fr, int fq) const {
        asm volatile("" : "+v"(fr), "+v"(fq));
        const int rt0 = u.pm * BM, col0 = u.pn * BM + wc * 32 + 8 * fq;
#pragma unroll
        for (int a0 = 0; a0 < 2; a0 += DN_AB) {
        u32x4 b[2][4][2]; float sc[2][4];
#pragma unroll
        for (int ai = a0; ai < a0 + DN_AB; ++ai)
#pragma unroll
            for (int m = 0; m < 4; ++m) { const int row = rt0 + wr * 64 + fr + ai * HALF + m * 16; sc[ai][m] = rsq_in[row];
#pragma unroll
                for (int bj = 0; bj < 2; ++bj) b[ai][m][bj] = *(const u32x4*)(XB + toff(row, col0 + bj * HALF, ldc)); }
#pragma unroll
        for (int ai = a0; ai < a0 + DN_AB; ++ai)
#pragma unroll
            for (int m = 0; m < 4; ++m) { const int row = rt0 + wr * 64 + fr + ai * HALF + m * 16; float sq = 0.f; const float r2 = __builtin_amdgcn_rcpf(sc[ai][m] * inv_k + eps);
#pragma unroll
                for (int bj = 0; bj < 2; ++bj) { const u32x4 x = b[ai][m][bj]; const f32x4 a0 = acc[ai][bj][m][0], a1 = acc[ai][bj][m][1];
                    const f32x4 o0 = (f32x4){bf_lo(x.x), bf_hi(x.x), bf_lo(x.y), bf_hi(x.y)} + a0 * r2, o1 = (f32x4){bf_lo(x.z), bf_hi(x.z), bf_lo(x.w), bf_hi(x.w)} + a1 * r2;
                    sq += ((o0[0] * o0[0] + o0[1] * o0[1]) + (o0[2] * o0[2] + o0[3] * o0[3])) + ((o1[0] * o1[0] + o1[1] * o1[1]) + (o1[2] * o1[2] + o1[3] * o1[3]));
                    u32x4 w; w.x = cvt_pk_bf16(o0[0], o0[1]); w.y = cvt_pk_bf16(o0[2], o0[3]); w.z = cvt_pk_bf16(o1[0], o1[1]); w.w = cvt_pk_bf16(o1[2], o1[3]);
                    *(u32x4*)(XB + toff(row, col0 + bj * HALF, ldc)) = w; }
                sq += __shfl_xor(sq, 16); sq += __shfl_xor(sq, 32);
                if (fq == 0) __hip_atomic_fetch_add(rowsq + row, sq, __ATOMIC_RELAXED, __HIP_MEMORY_SCOPE_AGENT); }
        }
    }
};

struct EpiRelu2 {
    static constexpr bool PERM = true, AFTER_DRAIN = false, MID = false;
    bf16_t* O; int ldc;
    __device__ __forceinline__ void operator()(const f32x4 (&acc)[2][2][4][2], const Unit& u, int wr, int wc, int fr, int fq) const {
        asm volatile("" : "+v"(fr), "+v"(fq));
        const int row0 = u.pm * BM + wr * 64 + fr, col0 = u.pn * BM + wc * 32 + 8 * fq;
#pragma unroll
        for (int ai = 0; ai < 2; ++ai)
#pragma unroll
            for (int m = 0; m < 4; ++m) { bf16_t* rowp = O + (size_t)(row0 + ai * HALF + m * 16) * ldc + col0;
#pragma unroll
                for (int bj = 0; bj < 2; ++bj) { f32x4 v0 = acc[ai][bj][m][0], v1 = acc[ai][bj][m][1];
#pragma unroll
                    for (int e = 0; e < 4; ++e) { const float a = fmaxf(v0[e], 0.f), b = fmaxf(v1[e], 0.f); v0[e] = a * a; v1[e] = b * b; }
                    u32x4 w; w.x = cvt_pk_bf16(v0[0], v0[1]); w.y = cvt_pk_bf16(v0[2], v0[3]); w.z = cvt_pk_bf16(v1[0], v1[1]); w.w = cvt_pk_bf16(v1[2], v1[3]);
                    EPI_ST16((u32x4*)(O + toff(row0 + ai * HALF + m * 16, col0 + bj * HALF, ldc)), w); } }
    }
};
struct EpiNull {
    static constexpr bool PERM = true, AFTER_DRAIN = false, MID = false;
    bf16_t* O;
    __device__ __forceinline__ void operator()(const f32x4 (&acc)[2][2][4][2], const Unit& u, int wr, int wc, int fr, int fq) const {
        asm volatile("" : "+v"(fr), "+v"(fq));
        float s = 0.f;
#pragma unroll
        for (int ai = 0; ai < 2; ++ai)
#pragma unroll
            for (int bj = 0; bj < 2; ++bj)
#pragma unroll
                for (int m = 0; m < 4; ++m)
#pragma unroll
                    for (int n = 0; n < 2; ++n) s += (acc[ai][bj][m][n][0] + acc[ai][bj][m][n][1]) + (acc[ai][bj][m][n][2] + acc[ai][bj][m][n][3]);
        if (s == 123456.789f) O[(wr * 4 + wc) * 64 + fr + 16 * fq] = 1;
    }
};
struct RepOrder {
    int n, pm, pn;
    __device__ bool next(int i, Unit& u) const { if (i >= n) return false; u.pm = pm; u.pn = pn; return true; }
    __device__ __forceinline__ void a_ready(const Unit&) const {}
    __device__ __forceinline__ void done(const Unit&) const {}
};

struct SharedOrder {
    StaticOrder so; bool shared; int x, r, SC, q;
    __device__ void init(int M, int N, int G_, int c_) { so.init(M, N, G_, c_); shared = (G_ == 256) && (so.nM % 16 == 0) && (so.nN % 4 == 0); x = c_ & 7; r = c_ >> 3; SC = so.nN / 4; q = so.nwg / 8; }
    __device__ bool next(int i, Unit& u) const {
        if (!shared) return so.next(i, u);
        const int idx = i * 32 + r; if (idx >= q) return false;
        const int bs = 8 * SC, blk = idx / bs, rem = idx - blk * bs;
        u.pm = (2 * blk + (x >> 2)) * 8 + (rem & 7); u.pn = (x & 3) * SC + (rem >> 3); return true;
    }
    __device__ __forceinline__ void a_ready(const Unit&) const {}
    __device__ __forceinline__ void done(const Unit&) const {}
};

template <class Base> struct RevCols {
    Base b;
    __device__ void init(int M, int N, int G_, int c_) { b.init(M, N, G_, c_); }
    __device__ bool next(int i, Unit& u) const { if (!b.next(i, u)) return false; u.pn = N_tiles() - 1 - u.pn; return true; }
    __device__ __forceinline__ int N_tiles() const { return b.nN; }
    __device__ __forceinline__ void a_ready(const Unit&) const {}
    __device__ __forceinline__ void done(const Unit&) const {}
};

template <int NPART> struct SplitOrder {
    StaticOrder so; int G, c, part_nwg, part_nM;
    __device__ void init(int M, int N, int G_, int c_) { so.init(M / NPART, N, G_, c_); G = G_; c = c_; part_nwg = so.nwg; part_nM = so.nM; }
    __device__ bool next(int i, Unit& u) const {
        const long L = (long)i * G + c; if (L >= (long)NPART * part_nwg) return false;
        const int part = (int)(L / part_nwg); so.map((int)(L - (long)part * part_nwg), u); u.pm += part * part_nM; return true;
    }
    __device__ __forceinline__ void a_ready(const Unit&) const {}
    __device__ __forceinline__ void done(const Unit&) const {}
};

template <int N1T> struct ColSplitOrder {
    StaticOrder s1, s2; int G, c;
    __device__ void init(int M, int N, int G_, int c_) { s1.init(M, N1T * BM, G_, c_); s2.init(M, N - N1T * BM, G_, c_); G = G_; c = c_; }
    __device__ bool next(int i, Unit& u) const {
        const long L = (long)i * G + c; if (L >= (long)s1.nwg + s2.nwg) return false;
        if (L < s1.nwg) s1.map((int)L, u); else { s2.map((int)(L - s1.nwg), u); u.pn += N1T; }
        return true;
    }
    __device__ __forceinline__ void a_ready(const Unit&) const {}
    __device__ __forceinline__ void done(const Unit&) const {}
};

template <int B1, int B2, int B3> struct ColSplit4 {
    int M, nN, G, c;
    __device__ void init(int M_, int N, int G_, int c_) { M = M_; nN = N / BM; G = G_; c = c_; }
    __device__ bool next(int i, Unit& u) const {
        long L = (long)i * G + c; const int nM = M / BM; int b0 = 0;
#pragma unroll
        for (int p = 0; p < 4; ++p) { const int b1 = p == 0 ? B1 : p == 1 ? B2 : p == 2 ? B3 : nN; const long n = (long)nM * (b1 - b0);
            if (L < n) { StaticOrder so; so.init(M, (b1 - b0) * BM, G, c); so.map((int)L, u); u.pn += b0; return true; }
            L -= n; b0 = b1; }
        return false;
    }
    __device__ __forceinline__ void a_ready(const Unit&) const {}
    __device__ __forceinline__ void done(const Unit&) const {}
};

struct ColSharedOrder {
    StaticOrder so; bool on; int x, r;
    __device__ void init(int M, int N, int G_, int c_) { so.init(M, N, G_, c_); on = (G_ == 256) && (so.nM == 96) && (so.nN == 60); x = c_ & 7; r = c_ >> 3; }
    __device__ bool next(int i, Unit& u) const {
        if (!on) return so.next(i, u);
        const int idx = i * 32 + r; if (idx >= 720) return false;
        const int part = idx < 576 ? idx / 192 : 3, rem = idx - part * 192, SC = part < 3 ? 4 : 3, bs = 8 * SC, blk = rem / bs, t = rem - blk * bs;
        u.pm = (2 * blk + (x >> 2)) * 8 + (t & 7); u.pn = part * 16 + (x & 3) * SC + (t >> 3); return true;
    }
    __device__ __forceinline__ void a_ready(const Unit&) const {}
    __device__ __forceinline__ void done(const Unit&) const {}
};
template <class E, bool M> struct MidT { struct type {}; };
template <class E> struct MidT<E, true> { typedef typename E::MidState type; };
template <class Epi, class Sched, bool ALIGN_EPI = false, bool SP2 = false>
__device__ __forceinline__ void gemm_phase(PG8_LAS unsigned char* lds, const Gemm g, const Sched& S, const Epi& E) {
    const int tid = threadIdx.x, wid = __builtin_amdgcn_readfirstlane(tid >> 6), lane = tid & 63, wr = wid >> 2, wc = wid & 3, fr = lane & 15, fq = lane >> 4;
    const int K = g.K, nt = K / BK;
    unsigned voffA[2], voffB[2];
#pragma unroll
    for (int i = 0; i < 2; ++i) { int R, C; stage_rc(tid * 16 + i * 8192, R, C); const int Rb = Epi::PERM ? ((R & ~31) + perm32(R & 31)) : R;
#if PG8_TILED
        voffA[i] = (unsigned)(R * BK + C) * 2u; voffB[i] = (unsigned)(Rb * BK + C) * 2u; }
    const size_t kstep = (size_t)BM * BK * 2;
    const size_t hstep = (size_t)HALF * BK * 2;
    const size_t tstep = (size_t)BM * K * 2;
#else
        voffA[i] = (unsigned)(R * K + C) * 2u; voffB[i] = (unsigned)(Rb * K + C) * 2u; }
    const size_t kstep = (size_t)(BK * 2);
    const size_t hstep = (size_t)HALF * K * 2;
    const size_t tstep = 2 * hstep;
#endif
    const unsigned ldsw = (unsigned)wid * 1024u;
    const int aoff = lds_byte(wr * 64 + fr, fq * 8), boff = lds_byte(wc * 32 + fr, fq * 8);
#define PG8_SA(b, h) (((b) * 2 + (h)) * HTB)
#define PG8_SB(b, h) ((4 + (b) * 2 + (h)) * HTB)
#ifndef PG8_AUX
#define PG8_AUX 0
#endif
#define PG8_STAGE(bufoff, gbase, voff) do { _Pragma("unroll") for (int _i = 0; _i < 2; ++_i) \
        __builtin_amdgcn_global_load_lds((const unsigned*)((const char*)(gbase) + (voff)[_i]), (PG8_LAS unsigned*)(lds + (bufoff) + ldsw + _i * 8192), 16, 0, PG8_AUX); } while (0)
#define PG8_LDA(dst, b, h) do { _Pragma("unroll") for (int m = 0; m < 4; ++m) _Pragma("unroll") for (int k = 0; k < 2; ++k) dst[m][k] = *(const PG8_LAS bf16x8*)(lds + PG8_SA(b, h) + aoff + m * 2048 + k * 1024); } while (0)
#define PG8_LDB(dst, b, h) do { _Pragma("unroll") for (int n = 0; n < 2; ++n) _Pragma("unroll") for (int k = 0; k < 2; ++k) dst[n][k] = *(const PG8_LAS bf16x8*)(lds + PG8_SB(b, h) + boff + n * 2048 + k * 1024); } while (0)
#define PG8_MMA(ai, bj, At, Bt) do { __builtin_amdgcn_s_setprio(1); _Pragma("unroll") for (int m = 0; m < 4; ++m) _Pragma("unroll") for (int n = 0; n < 2; ++n) _Pragma("unroll") for (int k = 0; k < 2; ++k) \
        acc[ai][bj][m][n] = __builtin_amdgcn_mfma_f32_16x16x32_bf16(Bt[n][k], At[m][k], acc[ai][bj][m][n], 0, 0, 0); __builtin_amdgcn_s_setprio(0); } while (0)
#define PG8_WAIT_V(n) asm volatile("s_waitcnt vmcnt(" #n ")" ::: "memory")
#define PG8_WAIT_L(n) asm volatile("s_waitcnt lgkmcnt(" #n ")" ::: "memory")
#define PG8_BAR __builtin_amdgcn_s_barrier()
#define PG8_SCHED __builtin_amdgcn_sched_barrier(0)
    Unit cur, nxt; int ui = 0; typename MidT<Epi, Epi::MID>::type ms;
    if (!S.next(0, cur)) return;
    f32x4 acc[2][2][4][2];
#pragma unroll
    for (int a = 0; a < 2; ++a)
#pragma unroll
        for (int b = 0; b < 2; ++b)
#pragma unroll
            for (int m = 0; m < 4; ++m)
#pragma unroll
                for (int n = 0; n < 2; ++n) acc[a][b][m][n] = (f32x4){0.f, 0.f, 0.f, 0.f};
    bf16x8 At[4][2], B0[2][2], B1[2][2];
    const char* cA = (const char*)g.A + (size_t)cur.pm * tstep; const char* cB = (const char*)g.Bt + (size_t)cur.pn * tstep;
    S.a_ready(cur);
    if constexpr (SP2) {
        PG8_STAGE(PG8_SB(0, 0), cB, voffB); PG8_STAGE(PG8_SB(0, 1), cB + hstep, voffB); PG8_STAGE(PG8_SA(0, 0), cA, voffA); PG8_STAGE(PG8_SA(0, 1), cA + hstep, voffA);
        if (wr == 1) PG8_BAR;
        PG8_WAIT_V(2); PG8_BAR;
        PG8_STAGE(PG8_SB(1, 0), cB + kstep, voffB); PG8_STAGE(PG8_SA(1, 0), cA + kstep, voffA); PG8_STAGE(PG8_SB(1, 1), cB + hstep + kstep, voffB);
        PG8_WAIT_V(6); PG8_BAR;
    } else {
        PG8_STAGE(PG8_SB(0, 0), cB, voffB); PG8_STAGE(PG8_SA(0, 0), cA, voffA); PG8_STAGE(PG8_SB(0, 1), cB + hstep, voffB); PG8_STAGE(PG8_SA(0, 1), cA + hstep, voffA);
        if (wr == 1) PG8_BAR;
        PG8_WAIT_V(4); PG8_BAR;
        PG8_STAGE(PG8_SB(1, 0), cB + kstep, voffB); PG8_STAGE(PG8_SA(1, 0), cA + kstep, voffA); PG8_STAGE(PG8_SB(1, 1), cB + hstep + kstep, voffB);
        PG8_WAIT_V(6); PG8_BAR;
    }
    for (;;) {
        const bool has_next = S.next(ui + 1, nxt);
        const char* nA = has_next ? (const char*)g.A + (size_t)nxt.pm * tstep : cA; const char* nB = has_next ? (const char*)g.Bt + (size_t)nxt.pn * tstep : cB;
        for (int t = 0; t < nt; t += 2) {
            if constexpr (Epi::MID) { if (t == (nt >> 1)) E.mid(acc, ms, cur, wr, wc, fr, fq); }
            const bool last = (t == nt - 2);
            const char* a1 = cA + (size_t)(t + 1) * kstep;
            const char* a2 = last ? nA : cA + (size_t)(t + 2) * kstep; const char* b2 = last ? nB : cB + (size_t)(t + 2) * kstep;
            const char* a3 = a2 + kstep; const char* b3 = b2 + kstep;
            if (last && has_next) S.a_ready(nxt);
            if constexpr (SP2) {
            PG8_LDB(B0, 0, 0); PG8_LDB(B1, 0, 1); PG8_SCHED; PG8_LDA(At, 0, 0); PG8_STAGE(PG8_SA(1, 1), a1 + hstep, voffA);
            PG8_WAIT_V(8); PG8_WAIT_L(0); PG8_BAR; PG8_MMA(0, 0, At, B0); PG8_MMA(0, 1, At, B1); PG8_BAR; PG8_SCHED;
            PG8_LDA(At, 0, 1); PG8_STAGE(PG8_SB(0, 0), b2, voffB); PG8_STAGE(PG8_SB(0, 1), b2 + hstep, voffB); PG8_STAGE(PG8_SA(0, 0), a2, voffA);
            PG8_WAIT_V(8); PG8_WAIT_L(0); PG8_BAR; PG8_MMA(1, 0, At, B0); PG8_MMA(1, 1, At, B1); PG8_BAR; PG8_SCHED;
            PG8_LDB(B0, 1, 0); PG8_LDB(B1, 1, 1); PG8_SCHED; PG8_LDA(At, 1, 0); PG8_STAGE(PG8_SA(0, 1), a2 + hstep, voffA);
            PG8_WAIT_V(8); PG8_WAIT_L(0); PG8_BAR; PG8_MMA(0, 0, At, B0); PG8_MMA(0, 1, At, B1); PG8_BAR; PG8_SCHED;
            PG8_LDA(At, 1, 1); PG8_STAGE(PG8_SB(1, 0), b3, voffB); PG8_STAGE(PG8_SB(1, 1), b3 + hstep, voffB); PG8_STAGE(PG8_SA(1, 0), a3, voffA);
            PG8_WAIT_V(8); PG8_WAIT_L(0); PG8_BAR; PG8_MMA(1, 0, At, B0); PG8_MMA(1, 1, At, B1); PG8_BAR; PG8_SCHED;
            } else {
            PG8_LDB(B0, 0, 0); PG8_SCHED; PG8_LDA(At, 0, 0); PG8_STAGE(PG8_SA(1, 1), a1 + hstep, voffA);
            PG8_WAIT_L(8); PG8_BAR; PG8_WAIT_L(0); PG8_MMA(0, 0, At, B0); PG8_BAR; PG8_SCHED;
            PG8_LDB(B1, 0, 1); PG8_STAGE(PG8_SB(0, 0), b2, voffB);
            PG8_BAR; PG8_WAIT_L(0); PG8_MMA(0, 1, At, B1); PG8_BAR;
            PG8_LDA(At, 0, 1); PG8_STAGE(PG8_SA(0, 0), a2, voffA);
            PG8_BAR; PG8_WAIT_L(0); PG8_MMA(1, 0, At, B0); PG8_BAR; PG8_SCHED;
            PG8_STAGE(PG8_SB(0, 1), b2 + hstep, voffB);
            PG8_WAIT_V(6); PG8_BAR; PG8_MMA(1, 1, At, B1); PG8_BAR;
            PG8_LDB(B0, 1, 0); PG8_SCHED; PG8_LDA(At, 1, 0); PG8_STAGE(PG8_SA(0, 1), a2 + hstep, voffA);
            PG8_WAIT_L(8); PG8_BAR; PG8_WAIT_L(0); PG8_MMA(0, 0, At, B0); PG8_BAR; PG8_SCHED;
            PG8_LDB(B1, 1, 1); PG8_STAGE(PG8_SB(1, 0), b3, voffB);
            PG8_BAR; PG8_WAIT_L(0); PG8_MMA(0, 1, At, B1); PG8_BAR;
            PG8_LDA(At, 1, 1); PG8_STAGE(PG8_SA(1, 0), a3, voffA);
            PG8_BAR; PG8_WAIT_L(0); PG8_MMA(1, 0, At, B0); PG8_BAR; PG8_SCHED;
            PG8_STAGE(PG8_SB(1, 1), b3 + hstep, voffB);
            PG8_WAIT_V(6); PG8_BAR; PG8_MMA(1, 1, At, B1); PG8_BAR;
            }
        }
        if constexpr (ALIGN_EPI) { if (wr == 0) PG8_BAR; }
        if constexpr (!Epi::AFTER_DRAIN) { if constexpr (Epi::MID) E(acc, ms, cur, wr, wc, fr, fq); else E(acc, cur, wr, wc, fr, fq); S.done(cur); }
        if (!has_next) break;
#pragma unroll
        for (int a = 0; a < 2; ++a)
#pragma unroll
            for (int b = 0; b < 2; ++b)
#pragma unroll
                for (int m = 0; m < 4; ++m)
#pragma unroll
                    for (int n = 0; n < 2; ++n) acc[a][b][m][n] = (f32x4){0.f, 0.f, 0.f, 0.f};
        cur = nxt; cA = nA; cB = nB; ++ui;
        if constexpr (ALIGN_EPI) { if (wr == 1) PG8_BAR; }
    }
    PG8_WAIT_V(0);
    if constexpr (!ALIGN_EPI) { if (wr == 0) PG8_BAR; }
    PG8_BAR;
    if constexpr (Epi::AFTER_DRAIN) { E.fused(acc, cur, wr, wc, fr, fq, lds, wid, lane); S.done(cur); }
#undef PG8_SA
#undef PG8_SB
#undef PG8_STAGE
#undef PG8_LDA
#undef PG8_LDB
#undef PG8_MMA
#undef PG8_WAIT_V
#undef PG8_WAIT_L
#undef PG8_BAR
#undef PG8_SCHED
}
}
namespace attn {
using bf16 = unsigned short;
constexpr int   D = 128, NW = 8, QBLK = 32, KVBLK = 64;
constexpr float SCALE = 0.088388347648318440f;
constexpr float THR = 8.f;
constexpr int SDEPTH = 1;
constexpr int LDQ = 2048, LDK = 512, LDO = 4096;
#ifndef ATTN_PVPIPE
#define ATTN_PVPIPE 0
#endif
#ifndef ATTN_DMA
#define ATTN_DMA 1
#endif
constexpr int NSTG = ATTN_DMA ? 3 : 2;
constexpr size_t SHM_V = KVBLK * D * 2, SHM_K = KVBLK * D * 2, SHM_ATTN = NSTG * SHM_V + NSTG * SHM_K + NW * 64 * 4;
using bf16x8 = __attribute__((ext_vector_type(8))) short;
using s16x4  = __attribute__((ext_vector_type(4))) short;
using f32x16 = __attribute__((ext_vector_type(16))) float;
using f32x8  = __attribute__((ext_vector_type(8))) float;
using u32x4  = __attribute__((ext_vector_type(4))) unsigned;
#define KSWZ(row, colB) ((row) * 256 + ((colB) ^ (((row) & 7) << 4)))
#define SBAR() __builtin_amdgcn_sched_barrier(0)
__device__ __forceinline__ int crow(int r, int hi) { return (r & 3) + 8 * (r >> 2) + 4 * hi; }
__device__ __forceinline__ unsigned cvtpk(float lo, float hi) {
  unsigned r; asm volatile("v_cvt_pk_bf16_f32 %0, %1, %2" : "=v"(r) : "v"(lo), "v"(hi)); return r;
}
struct StageB { using T = bf16x8;
  __device__ static __forceinline__ T ld8(const bf16* p) { return *reinterpret_cast<const bf16x8*>(p); }
  __device__ static __forceinline__ bf16x8 tobf(T x) { return x; } };
__device__ __forceinline__ void partialSM(f32x16& p0, f32x16& p1, float& m_reg, float& mn, float& alpha) {
  constexpr float C = SCALE * 1.4426950408889634f;
  float pmax = p0[0]; for (int r = 1; r < 16; ++r) pmax = fmaxf(pmax, p0[r]); for (int r = 0; r < 16; ++r) pmax = fmaxf(pmax, p1[r]);
  { auto rr = __builtin_amdgcn_permlane32_swap(__float_as_uint(pmax), __float_as_uint(pmax), false, false);
    pmax = fmaxf(__uint_as_float(rr[0]), __uint_as_float(rr[1])); }
  if (__builtin_expect(__all(pmax - m_reg <= THR / SCALE), 1)) { mn = m_reg; alpha = 1.f; }
  else { mn = fmaxf(m_reg, pmax); alpha = __builtin_amdgcn_exp2f((m_reg - mn) * C); m_reg = mn; }
  float mnC = -mn * C;
  for (int r = 0; r < 16; ++r) p0[r] = fmaf(p0[r], C, mnC); for (int r = 0; r < 16; ++r) p1[r] = fmaf(p1[r], C, mnC);
  for (int r = 0; r < 16; ++r) p0[r] = __builtin_amdgcn_exp2f(p0[r]);
}
__device__ __forceinline__ void finishSM(f32x16& p0, f32x16& p1, float alpha, float& l_reg, bf16x8& pa0, bf16x8& pa1, bf16x8& pa2, bf16x8& pa3) {
  for (int r = 0; r < 16; ++r) p1[r] = __builtin_amdgcn_exp2f(p1[r]);
  float ps = 0; for (int r = 0; r < 16; ++r) ps += p0[r]; for (int r = 0; r < 16; ++r) ps += p1[r];
  { auto rr = __builtin_amdgcn_permlane32_swap(__float_as_uint(ps), __float_as_uint(ps), false, false);
    ps = __uint_as_float(rr[0]) + __uint_as_float(rr[1]); }
  l_reg = l_reg * alpha + ps;
#define PK4(P, BASE, OUT) do { unsigned a0 = cvtpk(P[BASE + 0], P[BASE + 1]), a1 = cvtpk(P[BASE + 2], P[BASE + 3]);   \
    unsigned b0 = cvtpk(P[BASE + 4], P[BASE + 5]), b1 = cvtpk(P[BASE + 6], P[BASE + 7]);                              \
    auto r0 = __builtin_amdgcn_permlane32_swap(a0, b0, false, false); auto r1 = __builtin_amdgcn_permlane32_swap(a1, b1, false, false); \
    u32x4 w = {r0[0], r1[0], r0[1], r1[1]}; OUT = *reinterpret_cast<bf16x8*>(&w); } while (0)
  PK4(p0, 0, pa0); PK4(p0, 8, pa1); PK4(p1, 0, pa2); PK4(p1, 8, pa3);
#undef PK4
}
__device__ __forceinline__ void qkt(f32x16& p0, f32x16& p1, const bf16* Ks, const bf16x8* qr, int r32, int hi) {
  p0 = f32x16{}; p1 = f32x16{};
  for (int d0 = 0; d0 < 8; ++d0) { int cb = (d0 * 16 + hi * 8) * 2;
    bf16x8 b0 = *reinterpret_cast<const bf16x8*>((const char*)Ks + KSWZ(r32, cb));
    bf16x8 b1 = *reinterpret_cast<const bf16x8*>((const char*)Ks + KSWZ(32 + r32, cb));
    p0 = __builtin_amdgcn_mfma_f32_32x32x16_bf16(b0, qr[d0], p0, 0, 0, 0);
    p1 = __builtin_amdgcn_mfma_f32_32x32x16_bf16(b1, qr[d0], p1, 0, 0, 0); }
}
__device__ __forceinline__ int v_st(int k, int c) { const int kk = (k & ~0xC) | ((k & 4) << 1) | ((k & 8) >> 1); return ((kk >> 3) * 4 + (c >> 5)) * 512 + ((kk & 7) * 32 + (c & 31)) * 2; }
__device__ __forceinline__ int v_rd_base(int lane) { return ((lane & 3) << 3) | (((lane >> 2) & 3) << 6) | (((lane >> 4) & 1) << 5) | (((lane >> 5) & 1) << 8); }
constexpr int v_rd_off(int d0, int ks, int half) { return d0 * 512 + ks * 4096 + half * 2048; }
template <int OFF> __device__ __forceinline__ s16x4 tr_read(int vb) {
  s16x4 r; asm volatile("ds_read_b64_tr_b16 %0, %1 offset:%2" : "=&v"(r) : "v"(vb), "i"(OFF) : "memory"); return r;
}
template <int D0> __device__ __forceinline__ void pv_one(f32x16& od, int vb, bf16x8 pa0, bf16x8 pa1, bf16x8 pa2, bf16x8 pa3) {
  const s16x4 l0 = tr_read<v_rd_off(D0, 0, 0)>(vb), h0 = tr_read<v_rd_off(D0, 0, 1)>(vb), l1 = tr_read<v_rd_off(D0, 1, 0)>(vb), h1 = tr_read<v_rd_off(D0, 1, 1)>(vb);
  const s16x4 l2 = tr_read<v_rd_off(D0, 2, 0)>(vb), h2 = tr_read<v_rd_off(D0, 2, 1)>(vb), l3 = tr_read<v_rd_off(D0, 3, 0)>(vb), h3 = tr_read<v_rd_off(D0, 3, 1)>(vb);
  asm volatile("s_waitcnt lgkmcnt(0)" ::: "memory"); SBAR();
#define PK(L, H) (bf16x8){L[0], L[1], L[2], L[3], H[0], H[1], H[2], H[3]}
  od = __builtin_amdgcn_mfma_f32_32x32x16_bf16(pa0, PK(l0, h0), od, 0, 0, 0);
  od = __builtin_amdgcn_mfma_f32_32x32x16_bf16(pa1, PK(l1, h1), od, 0, 0, 0);
  od = __builtin_amdgcn_mfma_f32_32x32x16_bf16(pa2, PK(l2, h2), od, 0, 0, 0);
  od = __builtin_amdgcn_mfma_f32_32x32x16_bf16(pa3, PK(l3, h3), od, 0, 0, 0);
#undef PK
}
#if ATTN_PVPIPE
template <int D0> __device__ __forceinline__ void pv_rd(int vb, s16x4 (&f)[8]) {
  f[0] = tr_read<v_rd_off(D0, 0, 0)>(vb); f[1] = tr_read<v_rd_off(D0, 0, 1)>(vb); f[2] = tr_read<v_rd_off(D0, 1, 0)>(vb); f[3] = tr_read<v_rd_off(D0, 1, 1)>(vb);
  f[4] = tr_read<v_rd_off(D0, 2, 0)>(vb); f[5] = tr_read<v_rd_off(D0, 2, 1)>(vb); f[6] = tr_read<v_rd_off(D0, 3, 0)>(vb); f[7] = tr_read<v_rd_off(D0, 3, 1)>(vb);
}
__device__ __forceinline__ void pv_mm(f32x16& od, const s16x4 (&f)[8], bf16x8 pa0, bf16x8 pa1, bf16x8 pa2, bf16x8 pa3) {
#define PK(L, H) (bf16x8){L[0], L[1], L[2], L[3], H[0], H[1], H[2], H[3]}
  od = __builtin_amdgcn_mfma_f32_32x32x16_bf16(pa0, PK(f[0], f[1]), od, 0, 0, 0);
  od = __builtin_amdgcn_mfma_f32_32x32x16_bf16(pa1, PK(f[2], f[3]), od, 0, 0, 0);
  od = __builtin_amdgcn_mfma_f32_32x32x16_bf16(pa2, PK(f[4], f[5]), od, 0, 0, 0);
  od = __builtin_amdgcn_mfma_f32_32x32x16_bf16(pa3, PK(f[6], f[7]), od, 0, 0, 0);
#undef PK
}
template <int D0> __device__ __forceinline__ void pv_lo(int vb, s16x4 (&f)[4]) {
  f[0] = tr_read<v_rd_off(D0, 0, 0)>(vb); f[1] = tr_read<v_rd_off(D0, 0, 1)>(vb); f[2] = tr_read<v_rd_off(D0, 1, 0)>(vb); f[3] = tr_read<v_rd_off(D0, 1, 1)>(vb); }
template <int D0> __device__ __forceinline__ void pv_hi(int vb, s16x4 (&f)[4]) {
  f[0] = tr_read<v_rd_off(D0, 2, 0)>(vb); f[1] = tr_read<v_rd_off(D0, 2, 1)>(vb); f[2] = tr_read<v_rd_off(D0, 3, 0)>(vb); f[3] = tr_read<v_rd_off(D0, 3, 1)>(vb); }
#define PK(L, H) (bf16x8){L[0], L[1], L[2], L[3], H[0], H[1], H[2], H[3]}
#define PV_LO(od, f) do { od = __builtin_amdgcn_mfma_f32_32x32x16_bf16(pa0, PK(f[0], f[1]), od, 0, 0, 0); od = __builtin_amdgcn_mfma_f32_32x32x16_bf16(pa1, PK(f[2], f[3]), od, 0, 0, 0); } while (0)
#define PV_HI(od, f) do { od = __builtin_amdgcn_mfma_f32_32x32x16_bf16(pa2, PK(f[0], f[1]), od, 0, 0, 0); od = __builtin_amdgcn_mfma_f32_32x32x16_bf16(pa3, PK(f[2], f[3]), od, 0, 0, 0); } while (0)
#define LGKM(n) asm volatile("s_waitcnt lgkmcnt(" #n ")" ::: "memory")
__device__ __forceinline__ void pv_d0(f32x16* o, int vb, bf16x8 pa0, bf16x8 pa1, bf16x8 pa2, bf16x8 pa3) {
  s16x4 fa[4], fb[4], fc[4];
  pv_lo<0>(vb, fa); pv_hi<0>(vb, fb);
  pv_lo<1>(vb, fc); LGKM(8); SBAR(); PV_LO(o[0], fa); SBAR();
  pv_hi<1>(vb, fa); LGKM(8); SBAR(); PV_HI(o[0], fb); SBAR();
  pv_lo<2>(vb, fb); LGKM(8); SBAR(); PV_LO(o[1], fc); SBAR();
  pv_hi<2>(vb, fc); LGKM(8); SBAR(); PV_HI(o[1], fa); SBAR();
  pv_lo<3>(vb, fa); LGKM(8); SBAR(); PV_LO(o[2], fb); SBAR();
  pv_hi<3>(vb, fb); LGKM(8); SBAR(); PV_HI(o[2], fc); SBAR();
  LGKM(4); SBAR(); PV_LO(o[3], fa); SBAR();
  LGKM(0); SBAR(); PV_HI(o[3], fb);
}
#undef PK
#undef PV_LO
#undef PV_HI
#undef LGKM
#else
__device__ __forceinline__ void pv_d0(f32x16* o, int vb, bf16x8 pa0, bf16x8 pa1, bf16x8 pa2, bf16x8 pa3) {
  pv_one<0>(o[0], vb, pa0, pa1, pa2, pa3); pv_one<1>(o[1], vb, pa0, pa1, pa2, pa3); pv_one<2>(o[2], vb, pa0, pa1, pa2, pa3); pv_one<3>(o[3], vb, pa0, pa1, pa2, pa3);
}
#endif

__device__ __forceinline__ void attn_dense_body(const bf16* Qb, const bf16* __restrict__ Kh, const bf16* __restrict__ Vh,
                                                bf16* Obase, int orow0, int ocol0, int seq, char* lds, const float* qgain, int pos0) {
  using St = StageB; using SQ = StageB;
  int tid_ = threadIdx.x; asm volatile("" : "+v"(tid_));
  const int tid = tid_, wid = __builtin_amdgcn_readfirstlane(tid >> 6), lane = tid & 63, r32 = lane & 31, hi = lane >> 5;
  bf16* V_lds = (bf16*)lds; bf16* K_lds = (bf16*)(lds + NSTG * SHM_V);
  float* ws = (float*)(lds + NSTG * SHM_V + NSTG * SHM_K) + wid * 64; float* li_l = ws; float* al_l = ws + 32;
  float m_reg = -1e30f, l_reg = 0; f32x16 o[4] = {}; bf16x8 qr[8];
  const bf16* Qw = Qb + (long)(wid * QBLK + r32) * LDQ + hi * 8;
#pragma unroll
  for (int d0 = 0; d0 < 8; ++d0) qr[d0] = SQ::tobf(SQ::ld8(Qw + d0 * 16));
#if !ATTN_DMA
#ifndef ATTN_NO_QROPE
  {
    float ssq = 0.f;
#pragma unroll
    for (int d0 = 0; d0 < 8; ++d0)
#pragma unroll
      for (int e = 0; e < 8; ++e) { const float x = __uint_as_float((unsigned)(unsigned short)qr[d0][e] << 16); ssq = fmaf(x, x, ssq); }
    ssq += __shfl_xor(ssq, 32);
    const float rs = 1.0f / sqrtf(ssq * (1.0f / 128.0f) + 1e-6f);
    const int pos = pos0 + wid * QBLK + r32; const float prow = (float)(pos >> 6), pcol = (float)(pos & 63);
    float inv[4][4];
#pragma unroll
    for (int a = 0; a < 4; ++a)
#pragma unroll
      for (int j = 0; j < 4; ++j) inv[a][j] = __builtin_amdgcn_exp2f(-(float)(8 * a + 4 * hi + j) * (13.287712379549449f / 32.0f));
#pragma unroll
    for (int d0 = 0; d0 < 8; ++d0) { const float pf = d0 < 4 ? prow : pcol; const float* gp = qgain + 16 * d0 + 8 * hi;
      unsigned w[4];
#pragma unroll
      for (int j = 0; j < 4; ++j) { const float ang = pf * inv[d0 & 3][j]; const float cs = __cosf(ang), sn = __sinf(ang);
        const float x0 = __uint_as_float((unsigned)(unsigned short)qr[d0][2 * j] << 16), x1 = __uint_as_float((unsigned)(unsigned short)qr[d0][2 * j + 1] << 16);
        const float a = x0 * rs * gp[2 * j], b = x1 * rs * gp[2 * j + 1];
        w[j] = cvtpk(a * cs - b * sn, a * sn + b * cs); }
      u32x4 wv = {w[0], w[1], w[2], w[3]}; qr[d0] = *reinterpret_cast<bf16x8*>(&wv); }
  }
#endif
#endif
#if ATTN_DMA
  int koff[2], voff[2];
#pragma unroll
  for (int i = 0; i < 2; ++i) { const int q = i * 512 + wid * 64 + lane, row = q >> 4;
    koff[i] = row * LDK + 8 * ((q & 15) ^ (row & 7));
    const int kk = ((q >> 7) << 3) | ((q >> 2) & 7), k = (kk & ~0xC) | ((kk & 4) << 1) | ((kk & 8) >> 1), cc = (((q >> 5) & 3) << 2) | (q & 3);
    voff[i] = k * LDK + 8 * cc; }
  const unsigned ldsV = (unsigned)(uintptr_t)V_lds + (unsigned)wid * 1024u, ldsK = (unsigned)(uintptr_t)K_lds + (unsigned)wid * 1024u;
  const int vb0 = (int)(uintptr_t)V_lds + v_rd_base(lane);
#define ADMA(t) do { const int st_ = ((t) % 3) * (int)SHM_V; const long g_ = (long)(t) * KVBLK * LDK; _Pragma("unroll") for (int i_ = 0; i_ < 2; ++i_) { \
    __builtin_amdgcn_global_load_lds((const unsigned*)(Kh + g_ + koff[i_]), (__attribute__((address_space(3))) unsigned*)(ldsK + st_ + i_ * 8192), 16, 0, 0); \
    __builtin_amdgcn_global_load_lds((const unsigned*)(Vh + g_ + voff[i_]), (__attribute__((address_space(3))) unsigned*)(ldsV + st_ + i_ * 8192), 16, 0, 0); } } while (0)
#define KST(t) ((bf16*)((char*)K_lds + ((t) % 3) * SHM_K))
#define VST(t) (vb0 + ((t) % 3) * (int)SHM_V)
#define RESC(a) do { if (__any((a) < 1.f)) { if (hi == 0) al_l[r32] = (a); asm volatile("s_waitcnt lgkmcnt(0)" ::: "memory"); \
    for (int d = 0; d < 4; ++d) for (int r = 0; r < 16; ++r) o[d][r] *= al_l[crow(r, hi)]; } } while (0)
#define LAND() do { asm volatile("s_waitcnt vmcnt(0)" ::: "memory"); __syncthreads(); } while (0)
  f32x16 pA0, pA1, pB0, pB1; float mnA, mnB, alA, alB; bf16x8 pa0, pa1, pa2, pa3; const int NT = seq / KVBLK;
  ADMA(0); ADMA(1); SBAR();
#ifndef ATTN_NO_QROPE
  {
    float ssq = 0.f;
#pragma unroll
    for (int d0 = 0; d0 < 8; ++d0)
#pragma unroll
      for (int e = 0; e < 8; ++e) { const float x = __uint_as_float((unsigned)(unsigned short)qr[d0][e] << 16); ssq = fmaf(x, x, ssq); }
    ssq += __shfl_xor(ssq, 32);
    const float rs = 1.0f / sqrtf(ssq * (1.0f / 128.0f) + 1e-6f);
    const int pos = pos0 + wid * QBLK + r32; const float prow = (float)(pos >> 6), pcol = (float)(pos & 63);
    float inv[4][4];
#pragma unroll
    for (int a = 0; a < 4; ++a)
#pragma unroll
      for (int j = 0; j < 4; ++j) inv[a][j] = __builtin_amdgcn_exp2f(-(float)(8 * a + 4 * hi + j) * (13.287712379549449f / 32.0f));
#pragma unroll
    for (int d0 = 0; d0 < 8; ++d0) { const float pf = d0 < 4 ? prow : pcol; const float* gp = qgain + 16 * d0 + 8 * hi;
      unsigned w[4];
#pragma unroll
      for (int j = 0; j < 4; ++j) { const float ang = pf * inv[d0 & 3][j]; const float cs = __cosf(ang), sn = __sinf(ang);
        const float x0 = __uint_as_float((unsigned)(unsigned short)qr[d0][2 * j] << 16), x1 = __uint_as_float((unsigned)(unsigned short)qr[d0][2 * j + 1] << 16);
        const float a = x0 * rs * gp[2 * j], b = x1 * rs * gp[2 * j + 1];
        w[j] = cvtpk(a * cs - b * sn, a * sn + b * cs); }
      u32x4 wv = {w[0], w[1], w[2], w[3]}; qr[d0] = *reinterpret_cast<bf16x8*>(&wv); }
  }
#endif
  asm volatile("s_waitcnt vmcnt(4)" ::: "memory"); __syncthreads();
  qkt(pA0, pA1, KST(0), qr, r32, hi); partialSM(pA0, pA1, m_reg, mnA, alA);
  LAND(); ADMA(2);
  for (int j = 1; j + 1 < NT; j += 2) {
    SBAR(); qkt(pB0, pB1, KST(j), qr, r32, hi);
    finishSM(pA0, pA1, alA, l_reg, pa0, pa1, pa2, pa3); SBAR();
    pv_d0(o, VST(j - 1), pa0, pa1, pa2, pa3); partialSM(pB0, pB1, m_reg, mnB, alB);
    LAND(); ADMA(j + 2);
    RESC(alB);
    SBAR(); qkt(pA0, pA1, KST(j + 1), qr, r32, hi);
    finishSM(pB0, pB1, alB, l_reg, pa0, pa1, pa2, pa3); SBAR();
    pv_d0(o, VST(j), pa0, pa1, pa2, pa3); partialSM(pA0, pA1, m_reg, mnA, alA);
    LAND(); if (j + 3 < NT) ADMA(j + 3);
    RESC(alA);
  }
  SBAR(); qkt(pB0, pB1, KST(NT - 1), qr, r32, hi);
  finishSM(pA0, pA1, alA, l_reg, pa0, pa1, pa2, pa3); SBAR();
  pv_d0(o, VST(NT - 2), pa0, pa1, pa2, pa3); partialSM(pB0, pB1, m_reg, mnB, alB);
  RESC(alB);
  finishSM(pB0, pB1, alB, l_reg, pa0, pa1, pa2, pa3); SBAR();
  pv_d0(o, VST(NT - 1), pa0, pa1, pa2, pa3);
#undef ADMA
#undef KST
#undef VST
#undef LAND
#else
  const int sr = tid >> 4, sc = (tid & 15) * 8, vst0 = v_st(sr, sc), vst1 = v_st(32 + sr, sc);
  const int vb0 = (int)(uintptr_t)V_lds + v_rd_base(lane);
  struct { typename St::T vs0, vs1, ks0, ks1; } sr_[SDEPTH];
#define SLOAD(i, k0) do { sr_[i].vs0 = St::ld8(&Vh[(long)((k0) + sr) * LDK + sc]); sr_[i].vs1 = St::ld8(&Vh[(long)((k0) + 32 + sr) * LDK + sc]); \
    sr_[i].ks0 = St::ld8(&Kh[(long)((k0) + sr) * LDK + sc]); sr_[i].ks1 = St::ld8(&Kh[(long)((k0) + 32 + sr) * LDK + sc]); } while (0)
#define SWRITE(b, i) do { *(bf16x8*)((char*)V_lds + (b) * SHM_V + vst0) = St::tobf(sr_[i].vs0);          \
    *(bf16x8*)((char*)V_lds + (b) * SHM_V + vst1) = St::tobf(sr_[i].vs1); int kc = sc * 2;               \
    *(bf16x8*)((char*)K_lds + (b) * SHM_K + KSWZ(sr, kc)) = St::tobf(sr_[i].ks0);                       \
    *(bf16x8*)((char*)K_lds + (b) * SHM_K + KSWZ(32 + sr, kc)) = St::tobf(sr_[i].ks1); } while (0)
#define SWAIT() do { if constexpr (SDEPTH == 2) asm volatile("s_waitcnt vmcnt(4)" ::: "memory"); else asm volatile("s_waitcnt vmcnt(0)" ::: "memory"); } while (0)
#define RESC(a) do { if (__any((a) < 1.f)) { if (hi == 0) al_l[r32] = (a); asm volatile("s_waitcnt lgkmcnt(0)" ::: "memory"); \
    for (int d = 0; d < 4; ++d) for (int r = 0; r < 16; ++r) o[d][r] *= al_l[crow(r, hi)]; } } while (0)
  f32x16 pA0, pA1, pB0, pB1; float mnA, mnB, alA, alB; bf16x8 pa0, pa1, pa2, pa3; const int NT = seq / KVBLK;
  constexpr int SE = 0, SO = SDEPTH - 1;
  SLOAD(SE, 0); asm volatile("s_waitcnt vmcnt(0)" ::: "memory"); SWRITE(0, SE); __syncthreads();
  qkt(pA0, pA1, K_lds, qr, r32, hi); partialSM(pA0, pA1, m_reg, mnA, alA);
  SLOAD(SO, KVBLK); if constexpr (SDEPTH == 2) { if (2 < NT) SLOAD(SE, 2 * KVBLK); }
  SWAIT(); SWRITE(1, SO); __syncthreads();
  for (int j = 1; j + 1 < NT; j += 2) {
    SBAR(); qkt(pB0, pB1, (bf16*)((char*)K_lds + SHM_K), qr, r32, hi);
    finishSM(pA0, pA1, alA, l_reg, pa0, pa1, pa2, pa3); SBAR();
    SLOAD(SO, (j + SDEPTH) * KVBLK); SBAR();
    pv_d0(o, vb0, pa0, pa1, pa2, pa3); partialSM(pB0, pB1, m_reg, mnB, alB);
    __syncthreads(); SWAIT(); SWRITE(0, SE);
    RESC(alB); __syncthreads();
    SBAR(); qkt(pA0, pA1, K_lds, qr, r32, hi);
    finishSM(pB0, pB1, alB, l_reg, pa0, pa1, pa2, pa3); SBAR();
    if (SDEPTH == 1 || j + 3 < NT) SLOAD(SE, (j + 1 + SDEPTH) * KVBLK); SBAR();
    pv_d0(o, vb0 + (int)SHM_V, pa0, pa1, pa2, pa3); partialSM(pA0, pA1, m_reg, mnA, alA);
    __syncthreads(); SWAIT(); SWRITE(1, SO);
    RESC(alA); __syncthreads();
  }
  SBAR(); qkt(pB0, pB1, (bf16*)((char*)K_lds + SHM_K), qr, r32, hi);
  finishSM(pA0, pA1, alA, l_reg, pa0, pa1, pa2, pa3); SBAR();
  pv_d0(o, vb0, pa0, pa1, pa2, pa3); partialSM(pB0, pB1, m_reg, mnB, alB);
  __syncthreads(); RESC(alB);
  finishSM(pB0, pB1, alB, l_reg, pa0, pa1, pa2, pa3); SBAR();
  pv_d0(o, vb0 + (int)SHM_V, pa0, pa1, pa2, pa3);
#endif
  if (hi == 0) li_l[r32] = l_reg; asm volatile("s_waitcnt lgkmcnt(0)" ::: "memory");
  float rli[16];
#pragma unroll
  for (int r = 0; r < 16; ++r) rli[r] = __builtin_amdgcn_rcpf(li_l[crow(r, hi)]);
  __syncthreads();
  char* ost = lds + wid * 8192;
#pragma unroll
  for (int r = 0; r < 16; ++r) { const int orow = crow(r, hi);
#pragma unroll
    for (int d0 = 0; d0 < 4; ++d0) { const float v = o[d0][r] * rli[r]; unsigned u = __float_as_uint(v); u = (u + 0x7fffu + ((u >> 16) & 1u)) >> 16;
      *(unsigned short*)(ost + orow * 256 + (d0 * 32 + r32) * 2) = (unsigned short)u; } }
  asm volatile("s_waitcnt lgkmcnt(0)" ::: "memory");
#pragma unroll
  for (int i = 0; i < 8; ++i) { const int row = (lane >> 4) + 4 * i, ch = lane & 15;
    const u32x4 v = *(const u32x4*)(ost + row * 256 + ch * 16); *(u32x4*)(Obase + pg8::toff(orow0 + wid * QBLK + row, ocol0 + ch * 8, LDO)) = v; }
  __syncthreads();
#undef SLOAD
#undef SWRITE
#undef SWAIT
#undef RESC
}
}
constexpr int NWAVES = 8;
#ifndef MK_PER_PHASE
#define MK_PER_PHASE 0
#endif
#ifndef MK_STAGE
#define MK_STAGE 9
#endif

constexpr int D = 4096, NTOK_P = 4 * 4096, NTOK_S = 8192, NTOK = NTOK_P + NTOK_S;
constexpr int SEQ_P = 4096, SEQ_S = 8192;
constexpr int HD = 128, NQH = 16, NKVH = 4, AW = NQH * HD  , KVW = NKVH * HD  ;
constexpr int DR = 2048, LRU_NB = 16, LRU_BW = 128;
constexpr int FF = 4 * D, INW = AW + 2 * KVW + 2 * DR + 2 * D;
constexpr float NORM_EPS = 1e-6f;
#ifndef MLP_NCH
#define MLP_NCH 3
#endif
constexpr int MLP_CHUNKS = MLP_NCH, MLP_ROWS = NTOK / MLP_CHUNKS;
constexpr int LCH = 128, NCHUNK = NTOK / LCH;

constexpr size_t MiB = 1u << 20;
constexpr size_t WS_CTL = 0, CTL_ZERO_BYTES = 1 * MiB;
constexpr size_t WS_AGG = 1 * MiB;
constexpr size_t WS_CARRY = 8 * MiB;
constexpr size_t WS_WIN = 12 * MiB, WS_WCAT = 132 * MiB  , WS_WOUT = 164 * MiB, WS_WUP = 196 * MiB, WS_WDN = 324 * MiB;
constexpr size_t WS_A = 452 * MiB;
constexpr size_t WS_H1 = WS_A, WS_AR = WS_A  , WS_HM = WS_A;
constexpr size_t WS_B = 644 * MiB;
constexpr size_t WS_Q = WS_B, WS_K = WS_B + 96 * MiB, WS_V = WS_B + 120 * MiB, WS_XR = WS_B + 144 * MiB, WS_YR = WS_B + 240 * MiB;
constexpr size_t WS_MRG = WS_B, WS_HID = WS_B;
constexpr size_t WS_WF = 1028 * MiB;
constexpr size_t WS_END = 1030 * MiB;
static_assert(WS_WDN + (size_t)D * FF * 2 <= WS_A && WS_YR + (size_t)NTOK * DR * 2 <= WS_WF && WS_HID + (size_t)MLP_ROWS * FF * 2 <= WS_WF, "d_ws map");
constexpr int CW_TMO = 0, CW_CODE = 1;
constexpr int CW_RSQ1 = 32768, CW_RSQ2 = CW_RSQ1 + NTOK;
static_assert((CW_RSQ2 + NTOK) * 4 <= (int)CTL_ZERO_BYTES, "CTL words inside the memset region");
constexpr int CW_BAR = 4096;

constexpr int RING_OFF = 0, RING_BYTES = 131072;
constexpr int LDSCTL_OFF = RING_BYTES, MISC_OFF = LDSCTL_OFF + 320;
constexpr int LDS_BYTES = 147456;
static_assert(MISC_OFF + 128 <= LDS_BYTES && LDSCTL_OFF >= RING_BYTES, "LDS map");
#define GAS __attribute__((address_space(1)))
#define LAS __attribute__((address_space(3)))
typedef unsigned short bf16;
typedef unsigned v4u __attribute__((ext_vector_type(4)));
typedef float f32x4 __attribute__((ext_vector_type(4)));
typedef short bf16x8 __attribute__((ext_vector_type(8)));
typedef GAS unsigned gu32;
typedef GAS unsigned long long gu64;
#define RLX_AGENT __ATOMIC_RELAXED, __HIP_MEMORY_SCOPE_AGENT
#define LDS_WAIT() asm volatile("s_waitcnt lgkmcnt(0)" ::: "memory")
#define VM_WAIT() asm volatile("s_waitcnt vmcnt(0)" ::: "memory")
__device__ __forceinline__ unsigned long long rt() { return __builtin_amdgcn_s_memrealtime(); }
__device__ __forceinline__ unsigned f2bf(float f) { unsigned u = __builtin_bit_cast(unsigned, f); return (u + 0x7fffu + ((u >> 16) & 1u)) >> 16; }
__device__ __forceinline__ unsigned pk2(float lo, float hi) { return f2bf(lo) | (f2bf(hi) << 16); }

#define XB_TMO      128
#define XB_XCNT(j)  (256  + 64 * (j))
#define XB_XSUB(j)  (1280 + 64 * (j))
#define XB_XGEN(j)  (2304 + 64 * (j))
#define XB_TOP      3328
#define XB_TOPGEN   3392
#define XCD_BAR_WORDS 3456
#define XB_SPIN_CAP (1u << 18)

__device__ __forceinline__ unsigned xb_ld(unsigned* p)              { return __hip_atomic_load(p, __ATOMIC_RELAXED, __HIP_MEMORY_SCOPE_AGENT); }
__device__ __forceinline__ unsigned xb_add(unsigned* p, unsigned v) { return __hip_atomic_fetch_add(p, v, __ATOMIC_RELAXED, __HIP_MEMORY_SCOPE_AGENT); }
__device__ __forceinline__ unsigned xb_xcc_id() { return (unsigned)__builtin_amdgcn_s_getreg((3 << 11) | 20) & 0xFu; }
#define XB_SPIN(cond, bar) do { unsigned _sp = 0; while (cond) { __builtin_amdgcn_s_sleep(1); \
    if ((++_sp & 255u) == 0u) { if (xb_ld(&(bar)[XB_TMO])) break; if (_sp > XB_SPIN_CAP) { atomicAdd(&(bar)[XB_TMO], 1u); break; } } } } while (0)

struct XcdBarrier {
    unsigned* bar; unsigned x;
    volatile LAS unsigned* st;
};

__device__ __forceinline__ XcdBarrier xcd_barrier_post(unsigned* bar, volatile LAS unsigned* st) {
    XcdBarrier b; b.bar = bar; b.x = xb_xcc_id(); b.st = st;
    if (threadIdx.x == 0) (void)xb_add(&bar[XB_XCNT(b.x)], 1u);
    return b;
}
__device__ __forceinline__ void xcd_barrier_complete(unsigned* bar, unsigned x, unsigned& nloc, unsigned& nx) {
    const unsigned G = gridDim.x * gridDim.y * gridDim.z;
    unsigned sum, cnt, mine, sp = 0u;
    for (;;) {
        sum = 0u; cnt = 0u; mine = 0u;
#pragma unroll
        for (unsigned j = 0; j < 16; ++j) { const unsigned c = xb_ld(&bar[XB_XCNT(j)]); sum += c; cnt += (c > 0u) ? 1u : 0u; mine = (j == x) ? c : mine; }
        if (sum == G) break;
        __builtin_amdgcn_s_sleep(1);
        if ((++sp & 255u) == 0u) { if (xb_ld(&bar[XB_TMO])) break; if (sp > XB_SPIN_CAP) { atomicAdd(&bar[XB_TMO], 1u); break; } }
    }
    nloc = mine > 0u ? mine : 1u; nx = cnt > 0u ? cnt : 1u;
}

__device__ __forceinline__ void xcd_barrier(const XcdBarrier& b) {
    asm volatile("s_waitcnt vmcnt(0)" ::: "memory");
    __syncthreads();
    if (threadIdx.x == 0) {
        unsigned* bar = b.bar;
        __builtin_amdgcn_s_waitcnt(0);
        unsigned nloc = b.st[0], nx = b.st[1];
        if (nloc == 0u) { xcd_barrier_complete(bar, b.x, nloc, nx); b.st[0] = nloc; b.st[1] = nx; }
        const unsigned old = xb_add(&bar[XB_XSUB(b.x)], 1u);
        const unsigned gen = old / nloc;
        if (old + 1u == (gen + 1u) * nloc) {
            __builtin_amdgcn_fence(__ATOMIC_RELEASE, "agent");
            asm volatile("s_waitcnt vmcnt(0)" ::: "memory");
            const unsigned og = xb_add(&bar[XB_TOP], 1u);
            const unsigned tg = og / nx;
            if (og + 1u == (tg + 1u) * nx) xb_add(&bar[XB_TOPGEN], 1u);
            else XB_SPIN(xb_ld(&bar[XB_TOPGEN]) == tg, bar);
            __builtin_amdgcn_fence(__ATOMIC_ACQUIRE, "agent");
            xb_add(&bar[XB_XGEN(b.x)], 1u);
            asm volatile("s_waitcnt vmcnt(0)" ::: "memory");
        } else {
            XB_SPIN(xb_ld(&bar[XB_XGEN(b.x)]) == gen, bar);
            __builtin_amdgcn_fence(__ATOMIC_ACQUIRE, "agent");
            asm volatile("s_waitcnt vmcnt(0)" ::: "memory");
        }
    }
    __syncthreads();
}

struct Frame {
    LAS unsigned char* lds;
    volatile LAS unsigned* MISC;
    gu32* ctl;
    int tid, lane, wave;
    int vcu, G;
    const float* in[21]; float* out; unsigned char* ws;
};
__device__ __forceinline__ float wave_sum(float v) {
#pragma unroll
    for (int o = 1; o < 64; o <<= 1) v += __shfl_xor(v, o);
    return v;
}
__device__ __forceinline__ const float* xrow_ptr(const Frame& F, int row) { return row < NTOK_P ? F.in[0] + (size_t)row * D : F.in[1] + (size_t)(row - NTOK_P) * D; }

struct TrItem { const float* W; bf16* WT; const float* kgain; int N, ldw, koff, k0, n0; };
__device__ __forceinline__ void tr_load(const TrItem& t, int lane, float (&wv)[32]) {
#pragma unroll
    for (int i = 0; i < 32; ++i) { const int kk = 32 * (lane >> 5) + i; wv[i] = t.W[(size_t)(t.k0 + kk) * t.N + t.n0 + (lane & 31)]; }
}
__device__ __forceinline__ void tr_store(const TrItem& t, int lane, LAS float* scr_, const float (&wv)[32]) {
    LAS unsigned* scr = (LAS unsigned*)scr_; const int half = lane >> 5, n = lane & 31;
#pragma unroll
    for (int j = 0; j < 16; ++j) { float lo = wv[2 * j], hi = wv[2 * j + 1];
        if (t.kgain) { lo *= t.kgain[t.k0 + 32 * half + 2 * j]; hi *= t.kgain[t.k0 + 32 * half + 2 * j + 1]; }
        scr[(16 * half + j) * 33 + n] = pg8::cvt_pk_bf16(lo, hi); }
    LDS_WAIT(); asm volatile("" ::: "memory");
    const int c = lane & 7;
#pragma unroll
    for (int jj = 0; jj < 4; ++jj) { const int nn = (lane >> 3) + 8 * jj; const LAS unsigned* s = scr + (4 * c) * 33 + nn;
        v4u o; o.x = s[0]; o.y = s[33]; o.z = s[66]; o.w = s[99];
        *(GAS v4u*)(t.WT + pg8::toff(t.n0 + nn, t.koff + t.k0 + 8 * c, t.ldw)) = o; }
    LDS_WAIT(); asm volatile("" ::: "memory");
}
__device__ __forceinline__ void row_load(const float* xrow, int lane, f32x4 (&v)[16]) {
    const GAS f32x4* xr = (const GAS f32x4*)xrow + lane;
#pragma unroll
    for (int j = 0; j < 16; ++j) v[j] = xr[64 * j];
}
__device__ __forceinline__ void rms_store_bf16(const f32x4 (&v)[16], const float* gain, bf16* obase, int row, int lane) {
    const GAS f32x4* gr = (const GAS f32x4*)gain + lane; float s = 0.f;
#pragma unroll
    for (int j = 0; j < 16; ++j) s += (v[j].x * v[j].x + v[j].y * v[j].y) + (v[j].z * v[j].z + v[j].w * v[j].w);
    const float rs = 1.0f / sqrtf(wave_sum(s) * (1.f / D) + NORM_EPS);
#pragma unroll
    for (int j = 0; j < 16; ++j) { const f32x4 g = gr[64 * j]; const f32x4 o = v[j] * rs * g;
        *(GAS unsigned long long*)(obase + pg8::toff(row, 4 * (lane + 64 * j), D)) = (unsigned long long)pk2(o.x, o.y) | ((unsigned long long)pk2(o.z, o.w) << 32); }
}
__device__ __forceinline__ void scale_store_f32(const f32x4 (&v)[16], const float* gain, float sumsq, float* orow, int lane) {
    const GAS f32x4* gr = (const GAS f32x4*)gain + lane; const float rs = 1.0f / sqrtf(sumsq * (1.f / D) + NORM_EPS);
#pragma unroll
    for (int j = 0; j < 16; ++j) ((GAS f32x4*)orow)[lane + 64 * j] = v[j] * rs * gr[64 * j];
}
constexpr int I_IN = (D / 64) * (INW / 32), I_AT = (AW / 64) * (D / 32), I_RN = (DR / 64) * (D / 32), I_OUT = (D / 64) * (D / 32), I_UP = (D / 64) * (FF / 32), I_DN = (FF / 64) * (D / 32);
constexpr int NITEMS_B = I_AT + I_RN + I_OUT + I_UP + I_DN;
__device__ __forceinline__ TrItem tr_decode(const Frame& F, int r) {
    unsigned char* ws = F.ws; const float* W; bf16* WT; const float* kg = nullptr; int K, N, ldw, koff = 0;
    if (r < I_IN) { W = F.in[3]; K = D; N = INW; WT = (bf16*)(ws + WS_WIN); ldw = K; }
    else if ((r -= I_IN) < I_AT) { W = F.in[13]; K = AW; N = D; WT = (bf16*)(ws + WS_WCAT); ldw = 2 * AW; }
    else if ((r -= I_AT) < I_RN) { W = F.in[14]; K = DR; N = D; WT = (bf16*)(ws + WS_WCAT); ldw = 2 * AW; koff = AW; }
    else if ((r -= I_RN) < I_OUT) { W = F.in[16]; K = D; N = D; WT = (bf16*)(ws + WS_WOUT); ldw = K; }
    else if ((r -= I_OUT) < I_UP) { W = F.in[18]; K = D; N = FF; WT = (bf16*)(ws + WS_WUP); ldw = K; kg = F.in[17]; }
    else { r -= I_UP; W = F.in[19]; K = FF; N = D; WT = (bf16*)(ws + WS_WDN); ldw = K; }
    const int nblk = N / 32, kb = r / nblk, nb = r % nblk;
    return TrItem{W, WT, kg, N, ldw, koff, 64 * kb, 32 * nb};
}
__device__ __forceinline__ void tr_items(Frame& F, LAS float* scr, int lo, int hi, int w, int nw) {
    if (lo + w < hi) {
        TrItem cur = tr_decode(F, lo + w); float wa[32], wb[32];
        tr_load(cur, F.lane, wa);
        for (int it = lo + w; it < hi; it += 2 * nw) {
            const bool h1 = it + nw < hi, h2 = it + 2 * nw < hi; TrItem nx = cur, n2 = cur;
            if (h1) { nx = tr_decode(F, it + nw); tr_load(nx, F.lane, wb); }
            tr_store(cur, F.lane, scr, wa);
            if (h2) { n2 = tr_decode(F, it + 2 * nw); tr_load(n2, F.lane, wa); }
            if (h1) tr_store(nx, F.lane, scr, wb);
            cur = n2;
        }
    }
}
__device__ __forceinline__ void p0_prologue(Frame& F) {
    LAS float* scr = (LAS float*)(F.lds + RING_OFF + F.wave * 16384);
    const int gw = F.vcu * NWAVES + F.wave, NGW = F.G * NWAVES;
    unsigned char* ws = F.ws;
    tr_items(F, scr, 0, I_IN + NITEMS_B, gw, NGW);
    for (int e = gw * 64 + F.lane; e < 2 * LRU_NB * NWAVES * 2 * 4 * 64; e += NGW * 64) {
        const int ln = e & 63, ks = (e >> 6) & 3, g = (e >> 8) & 1, wv = (e >> 9) & 7, n = (e >> 12) & 15, z = e >> 16;
        const float* wp = (g ? F.in[10] : F.in[8]) + (size_t)((z * LRU_NB + n) * LRU_BW + 32 * ks + 8 * (ln >> 4)) * LRU_BW + 16 * wv + (ln & 15);
        v4u o; o.x = pk2(wp[0 * LRU_BW], wp[1 * LRU_BW]); o.y = pk2(wp[2 * LRU_BW], wp[3 * LRU_BW]); o.z = pk2(wp[4 * LRU_BW], wp[5 * LRU_BW]); o.w = pk2(wp[6 * LRU_BW], wp[7 * LRU_BW]);
        *(GAS v4u*)(ws + WS_WF + (size_t)e * 16) = o; }
    if (gw < NTOK) {
        f32x4 va[16], vb[16]; row_load(xrow_ptr(F, gw), F.lane, va);
        for (int m = gw; m < NTOK; m += 2 * NGW) {
            const bool h1 = m + NGW < NTOK, h2 = m + 2 * NGW < NTOK;
            if (h1) row_load(xrow_ptr(F, m + NGW), F.lane, vb);
            rms_store_bf16(va, F.in[2], (bf16*)(ws + WS_H1), m, F.lane);
            if (h2) row_load(xrow_ptr(F, m + 2 * NGW), F.lane, va);
            if (h1) rms_store_bf16(vb, F.in[2], (bf16*)(ws + WS_H1), m + NGW, F.lane);
        }
    }
}
typedef unsigned short u16;
__device__ __forceinline__ float bf2f(unsigned short b) { return __uint_as_float((unsigned)b << 16); }
__device__ __forceinline__ float bflo(unsigned w) { return __uint_as_float(w << 16); }
__device__ __forceinline__ float bfhi(unsigned w) { return __uint_as_float(w & 0xffff0000u); }
__device__ __forceinline__ float sigm(float x) { return __builtin_amdgcn_rcpf(1.0f + __builtin_amdgcn_exp2f(-1.4426950408889634f * x)); }
__device__ __forceinline__ int seq_pos(int tok) { return tok < NTOK_P ? (tok & (SEQ_P - 1)) : tok - NTOK_P; }

#ifdef ATTN_NO_QROPE
constexpr int QKR_G = 5;
#else
constexpr int QKR_G = 1;
#endif
__device__ __forceinline__ void qk_norm_rope(Frame& F, bf16* Q, bf16* K) {
    const int gw = F.vcu * NWAVES + F.wave, NGW = F.G * NWAVES, lane = F.lane, c16 = lane & 15;
    float inv[4];
#pragma unroll
    for (int j = 0; j < 4; ++j) { const int pi = (4 * c16 + j) & 31; inv[j] = __builtin_amdgcn_exp2f(-(float)pi * (13.287712379549449f / 32.0f)); }
    float gq[8], gk[8];
#pragma unroll
    for (int e = 0; e < 8; ++e) { gq[e] = F.in[4][8 * c16 + e]; gk[e] = F.in[5][8 * c16 + e]; }
    constexpr int UB = 4;
    for (int it0 = gw; it0 < NTOK * QKR_G; it0 += NGW * UB) {
        v4u w[UB]; bf16* p[UB];
#pragma unroll
        for (int b = 0; b < UB; ++b) { const int it = it0 + b * NGW; const int tok = it / QKR_G, g = QKR_G == 1 ? 4 : it % QKR_G;
            p[b] = (g < 4 ? Q + (size_t)tok * AW + g * 512 : K + (size_t)tok * KVW) + (lane >> 4) * HD + 8 * c16;
            if (it < NTOK * QKR_G) w[b] = *(const GAS v4u*)p[b]; else w[b] = (v4u){0u, 0u, 0u, 0u}; }
#pragma unroll
        for (int b = 0; b < UB; ++b) { const int it = it0 + b * NGW; const int tok = it / QKR_G, g = QKR_G == 1 ? 4 : it % QKR_G;
            float x[8] = {bflo(w[b].x), bfhi(w[b].x), bflo(w[b].y), bfhi(w[b].y), bflo(w[b].z), bfhi(w[b].z), bflo(w[b].w), bfhi(w[b].w)};
            float s = 0.f;
#pragma unroll
            for (int e = 0; e < 8; ++e) s += x[e] * x[e];
            s += __shfl_xor(s, 1); s += __shfl_xor(s, 2); s += __shfl_xor(s, 4); s += __shfl_xor(s, 8);
            const float rs = 1.0f / sqrtf(s * (1.0f / HD) + NORM_EPS);
            const int pos = seq_pos(tok < NTOK ? tok : 0); const float pf = (float)(c16 < 8 ? (pos >> 6) : (pos & 63));
            float y[8];
#pragma unroll
            for (int j = 0; j < 4; ++j) { const float ang = pf * inv[j]; const float cs = cosf(ang), sn = sinf(ang);
                const float a = x[2 * j] * rs * (g < 4 ? gq[2 * j] : gk[2 * j]), bb = x[2 * j + 1] * rs * (g < 4 ? gq[2 * j + 1] : gk[2 * j + 1]);
                y[2 * j] = a * cs - bb * sn; y[2 * j + 1] = a * sn + bb * cs; }
            v4u o; o.x = pk2(y[0], y[1]); o.y = pk2(y[2], y[3]); o.z = pk2(y[4], y[5]); o.w = pk2(y[6], y[7]);
            if (it < NTOK * QKR_G) *(GAS v4u*)p[b] = o; }
    }
}

constexpr int LROW = 272;
constexpr int L_XC = 0, L_YT = 36864;
template <int DIR, bool FINAL>
__device__ __forceinline__ void lru_dir(LAS unsigned char* lds, const pg8::bf16x8* wf  , pg8::f32x4 (&hf)[8], float ba, float bi, float sp, float cin,
                                        int lane, int chl, float* aggP, float* aggH) {
    using pg8::f32x4; using pg8::bf16x8;
    const int fr = lane & 15, quad = lane >> 4;
    bf16x8 Bf[2][4];
#pragma unroll
    for (int g = 0; g < 2; ++g)
#pragma unroll
        for (int ks = 0; ks < 4; ++ks) Bf[g][ks] = wf[(g * 4 + ks) * 64 + lane];
    f32x4 accR[8], accI[8];
#pragma unroll
    for (int m = 0; m < 8; ++m) { accR[m] = (f32x4){0.f, 0.f, 0.f, 0.f}; accI[m] = (f32x4){0.f, 0.f, 0.f, 0.f}; }
    const int arow = 32 * (fr >> 2) + (fr & 3);
#pragma unroll
    for (int m = 0; m < 8; ++m)
#pragma unroll
        for (int ks = 0; ks < 4; ++ks) {
            const bf16x8 a = *(const LAS bf16x8*)(lds + L_XC + (arow + 4 * m) * LROW + (32 * ks + 8 * quad) * 2);
            accR[m] = __builtin_amdgcn_mfma_f32_16x16x32_bf16(a, Bf[0][ks], accR[m], 0, 0, 0);
            accI[m] = __builtin_amdgcn_mfma_f32_16x16x32_bf16(a, Bf[1][ks], accI[m], 0, 0, 0);
            if (ks == 3 && (m & 1)) __builtin_amdgcn_sched_barrier(0);
        }
    float cp = 1.f, hl = 0.f;
#pragma unroll
    for (int mm = 0; mm < 8; ++mm)
#pragma unroll
        for (int rr = 0; rr < 4; ++rr) {
            const int m = DIR ? 7 - mm : mm, r = DIR ? 3 - rr : rr;
            const int tau = 32 * quad + 4 * m + r;
            const float xv = bf2f(*(const LAS u16*)(lds + L_XC + tau * LROW + chl * 2));
            const float rg = sigm(accR[m][r] + ba), ig = sigm(accI[m][r] + bi);
            const float la = -8.0f * rg * sp;
            const float a = __builtin_amdgcn_exp2f(1.4426950408889634f * la);
            const float om = fmaf(-a, a, 1.0f);
            const float u = __builtin_amdgcn_sqrtf(om) * (ig * xv);
            cp = cp * a; hl = a * hl + u;
            accR[m][r] = cp; accI[m][r] = hl;
            if (rr == 3) __builtin_amdgcn_sched_barrier(0);
        }
    float Pq[4], Hq[4];
#pragma unroll
    for (int q = 0; q < 4; ++q) { Pq[q] = __shfl(cp, fr + 16 * q); Hq[q] = __shfl(hl, fr + 16 * q); }
    float cm;
    if (DIR == 0) { const float c1 = Pq[0] * cin + Hq[0], c2 = Pq[1] * c1 + Hq[1], c3 = Pq[2] * c2 + Hq[2], c4 = Pq[3] * c3 + Hq[3];
        cm = quad == 0 ? cin : quad == 1 ? c1 : quad == 2 ? c2 : c3; *aggH = c4; }
    else { const float d2 = Pq[3] * cin + Hq[3], d1 = Pq[2] * d2 + Hq[2], d0 = Pq[1] * d1 + Hq[1], de = Pq[0] * d0 + Hq[0];
        cm = quad == 3 ? cin : quad == 2 ? d2 : quad == 1 ? d1 : d0; *aggH = de; }
    *aggP = (Pq[0] * Pq[1]) * (Pq[2] * Pq[3]);
    if (FINAL) {
#pragma unroll
        for (int m = 0; m < 8; ++m) { const f32x4 h = accI[m] + accR[m] * cm; hf[m] = DIR == 0 ? h : hf[m] + h; }
    }
}
template <bool FINAL>
__device__ __forceinline__ void lru_phase(Frame& F, const bf16* XR, const bf16* YR, bf16* REC) {
    using pg8::f32x4; using pg8::bf16x8;
    LAS unsigned char* lds = F.lds + RING_OFF;
    const int w = F.wave;
    float* AGG = (float*)(F.ws + WS_AGG); const float* CARRY = (const float*)(F.ws + WS_CARRY);
    const bf16x8* WF = (const bf16x8*)(F.ws + WS_WF); float ba[2], bi[2], sp[2]; int cur_n = -1;
    for (int L = blockIdx.x; L < NCHUNK * LRU_NB; L += F.G) {
        const int chunk = L / LRU_NB, n = L % LRU_NB, t0 = chunk * LCH;
        int tid = F.tid; asm volatile("" : "+v"(tid));
        const int lane = tid & 63, fr = lane & 15, quad = lane >> 4, chl = 16 * w + fr;
        const int cg = tid & 15, tg = tid >> 4;
        if (n != cur_n) {
            cur_n = n;
#pragma unroll
            for (int z = 0; z < 2; ++z) { const int ch = z * DR + n * LRU_BW + chl; ba[z] = F.in[9][ch]; bi[z] = F.in[11][ch]; sp[z] = log1pf(expf(-F.in[12][ch])); }
        }
        __syncthreads();
        {
            const int ch0 = n * LRU_BW + 8 * cg; const int p0 = seq_pos(t0), slen = t0 < NTOK_P ? SEQ_P : SEQ_S;
            float cw[4][8], cb[8];
#pragma unroll
            for (int j = 0; j < 4; ++j)
#pragma unroll
                for (int e = 0; e < 8; ++e) cw[j][e] = F.in[6][j * DR + ch0 + e];
#pragma unroll
            for (int e = 0; e < 8; ++e) cb[e] = F.in[7][ch0 + e];
            v4u xin[7];
#pragma unroll
            for (int i = 0; i < 7; ++i) { const int lt = 4 * tg - 1 + i, p = p0 + lt;
                xin[i] = (p >= 0 && p < slen) ? *(const GAS v4u*)(XR + (size_t)(t0 + lt) * DR + ch0) : (v4u){0u, 0u, 0u, 0u}; }
#pragma unroll
            for (int k = 0; k < 4; ++k) { float o[8];
#pragma unroll
                for (int e = 0; e < 8; ++e) o[e] = cb[e];
#pragma unroll
                for (int j = 0; j < 4; ++j) { const v4u v = xin[k + j]; const float xv[8] = {bflo(v.x), bfhi(v.x), bflo(v.y), bfhi(v.y), bflo(v.z), bfhi(v.z), bflo(v.w), bfhi(v.w)};
#pragma unroll
                    for (int e = 0; e < 8; ++e) o[e] += cw[j][e] * xv[e]; }
                v4u pk; pk.x = pk2(o[0], o[1]); pk.y = pk2(o[2], o[3]); pk.z = pk2(o[4], o[5]); pk.w = pk2(o[6], o[7]);
                *(LAS v4u*)(lds + L_XC + (4 * tg + k) * LROW + cg * 16) = pk; }
            if (FINAL) {
#pragma unroll
                for (int k = 0; k < 4; ++k) *(LAS v4u*)(lds + L_YT + (4 * tg + k) * LROW + cg * 16) = *(const GAS v4u*)(YR + (size_t)(t0 + 4 * tg + k) * DR + ch0); }
        }
        float cinf = 0.f, cinb = 0.f;
        if (FINAL) { cinf = CARRY[((size_t)chunk * 2 + 0) * DR + n * LRU_BW + chl]; cinb = CARRY[((size_t)chunk * 2 + 1) * DR + n * LRU_BW + chl]; }
        __syncthreads();
        f32x4 hf[8]; float aP, aH;
        lru_dir<0, FINAL>(lds, WF + (size_t)((0 * LRU_NB + n) * NWAVES + w) * 512, hf, ba[0], bi[0], sp[0], cinf, lane, chl, &aP, &aH);
        if (!FINAL && quad == 0) { float* ag = AGG + (size_t)chunk * 4 * DR + n * LRU_BW + chl; ag[0] = aP; ag[DR] = aH; }
        lru_dir<1, FINAL>(lds, WF + (size_t)((1 * LRU_NB + n) * NWAVES + w) * 512, hf, ba[1], bi[1], sp[1], cinb, lane, chl, &aP, &aH);
        if (!FINAL && quad == 0) { float* ag = AGG + (size_t)chunk * 4 * DR + n * LRU_BW + chl; ag[2 * DR] = aP; ag[3 * DR] = aH; }
        if (FINAL) {
#pragma unroll
            for (int m = 0; m < 8; ++m)
#pragma unroll
                for (int r = 0; r < 4; ++r) { const int tau = 32 * quad + 4 * m + r; LAS u16* yp = (LAS u16*)(lds + L_YT + tau * LROW + chl * 2);
                    const float y = bf2f(*yp); const float ge = y * sigm(1.5957691216057308f * (y + 0.044715f * y * y * y));
                    *yp = (u16)f2bf(hf[m][r] * ge); if (r == 3) __builtin_amdgcn_sched_barrier(0); }
            __syncthreads();
#pragma unroll
            for (int k = 0; k < 4; ++k) *(GAS v4u*)(REC + pg8::toff(t0 + 4 * tg + k, DR + n * LRU_BW + 8 * cg, 2 * DR)) = *(const LAS v4u*)(lds + L_YT + (4 * tg + k) * LROW + cg * 16);
        }
    }
    __syncthreads();
}
__device__ __forceinline__ void lru_carry(Frame& F) {
    const float* AGG = (const float*)(F.ws + WS_AGG); float* CARRY = (float*)(F.ws + WS_CARRY);
    const int per = (5 * 2 * DR + F.G - 1) / F.G;
    if (F.tid < per) {
        const int id = F.vcu * per + F.tid;
        if (id < 5 * 2 * DR) {
            const int s = id / (2 * DR), dir = (id / DR) & 1, ch = id % DR;
            const int c0 = s < 4 ? 32 * s : 128, nc = s < 4 ? 32 : 64;
            float h = 0.f;
            for (int b = 0; b < nc; b += 16) {
                float P[16], H[16];
#pragma unroll
                for (int j = 0; j < 16; ++j) { const int c = dir == 0 ? c0 + b + j : c0 + nc - 1 - b - j; P[j] = AGG[((size_t)c * 4 + 2 * dir) * DR + ch]; H[j] = AGG[((size_t)c * 4 + 2 * dir + 1) * DR + ch]; }
#pragma unroll
                for (int j = 0; j < 16; ++j) { const int c = dir == 0 ? c0 + b + j : c0 + nc - 1 - b - j; CARRY[((size_t)c * 2 + dir) * DR + ch] = h; h = P[j] * h + H[j]; }
            }
        }
    }
}
__device__ __forceinline__ void attn_phase_all(Frame& F, char* lds, const bf16* Q, const bf16* K, const bf16* V, bf16* O) {
    for (int L = blockIdx.x; L < 1536; L += F.G) {
        const int c = L & 255, i = L >> 8, xcd = c & 7, rank = c >> 3;
        int row0, head, kvh, qb, seq;
        if (i < 2) { const int idx = i * 32 + rank, grp = xcd >> 1, u = (xcd & 1) * 64 + idx; kvh = grp; head = grp * 4 + (u >> 5); qb = u & 31; row0 = NTOK_P; seq = SEQ_S; }
        else { const int idx = (i - 2) * 32 + rank, grp = 2 * xcd + (idx >> 6), v = idx & 63, b = grp >> 2; kvh = grp & 3; head = kvh * 4 + (v >> 4); qb = v & 15; row0 = b * SEQ_P; seq = SEQ_P; }
        attn::attn_dense_body(Q + (size_t)(row0 + qb * 256) * AW + head * HD, K + (size_t)row0 * KVW + kvh * HD, V + (size_t)row0 * KVW + kvh * HD,
                              O, row0 + qb * 256, head * HD, seq, lds, F.in[4], qb * 256);
    }
}
#ifndef MK_DUP
#define MK_DUP -1
#endif
#ifndef MK_REP30
#define MK_REP30 1
#endif
#ifndef MK_NO_XB
#define MK_NO_XB 0
#endif
#ifndef ORD_1
#define ORD_1 pg8::StaticOrder
#endif
#ifndef ORD_5
#define ORD_5 pg8::SharedOrder
#endif
#ifndef ORD_6
#define ORD_6 pg8::SharedOrder
#endif
#ifndef ORD_UP
#define ORD_UP pg8::StaticOrder
#endif
#ifndef ORD_DN
#define ORD_DN pg8::SharedOrder
#endif
#ifndef WGM_UP
#define WGM_UP 8
#endif
#ifndef WGM_DN
#define WGM_DN 8
#endif
#ifndef WGM_1
#define WGM_1 8
#endif
#ifndef X2_F32
#define X2_F32 false
#endif
#ifndef PG_ALIGN
#define PG_ALIGN true
#endif
#ifndef PG_SP2
#define PG_SP2 true
#endif
constexpr int NPH = 8 + 2 * MLP_CHUNKS;
struct Args { const float* in[21]; float* out; unsigned char* ws; int ph_lo, ph_hi; };
__global__ void __launch_bounds__(NWAVES * 64, 2) mk_fwd(Args args) {
    extern __shared__ __attribute__((aligned(16))) unsigned char lds[];
    Frame F;
    F.lds = (LAS unsigned char*)lds;
    F.MISC = (volatile LAS unsigned*)(F.lds + MISC_OFF);
    F.tid = threadIdx.x; F.lane = F.tid & 63; F.wave = __builtin_amdgcn_readfirstlane(F.tid >> 6);
    F.G = gridDim.x; { const int bx = blockIdx.x; F.vcu = (F.G % 8 == 0) ? (bx % 8) * (F.G / 8) + bx / 8 : bx; }
    unsigned char* ws = args.ws; F.ws = ws; F.out = args.out;
#pragma unroll
    for (int i = 0; i < 21; ++i) F.in[i] = args.in[i];
    F.ctl = (gu32*)(ws + WS_CTL);
    for (int u = F.tid; u < (LDS_BYTES - LDSCTL_OFF) / 4; u += NWAVES * 64) ((LAS unsigned*)(F.lds + LDSCTL_OFF))[u] = 0u;
    __syncthreads();
    XcdBarrier bar; bar.bar = (unsigned*)(F.ctl + CW_BAR); bar.x = 0; bar.st = nullptr;
    if (!MK_PER_PHASE) bar = xcd_barrier_post((unsigned*)(F.ctl + CW_BAR), F.MISC + 8);
    const int lo = args.ph_lo, hi = args.ph_hi;
#define IN(k) (lo <= (k) && (k) < hi)
#define SEAM(k) do { if (IN(k) && IN((k) + 1)) xcd_barrier(bar); } while (0)
    const int gw = F.vcu * NWAVES + F.wave, NGW = F.G * NWAVES;
    bf16* const W_IN = (bf16*)(ws + WS_WIN); bf16* const W_CAT = (bf16*)(ws + WS_WCAT); bf16* const W_OUT = (bf16*)(ws + WS_WOUT);
    bf16* const W_UP = (bf16*)(ws + WS_WUP); bf16* const W_DN = (bf16*)(ws + WS_WDN);
    bf16* const H1 = (bf16*)(ws + WS_H1); bf16* const AR = (bf16*)(ws + WS_AR); bf16* const HM = (bf16*)(ws + WS_HM);
    bf16* const QB = (bf16*)(ws + WS_Q); bf16* const KB = (bf16*)(ws + WS_K); bf16* const VB = (bf16*)(ws + WS_V); bf16* const XR = (bf16*)(ws + WS_XR); bf16* const YR = (bf16*)(ws + WS_YR);
    bf16* const MRG = (bf16*)(ws + WS_MRG); bf16* const HID = (bf16*)(ws + WS_HID);
    float* const RSQ1 = (float*)(F.ctl + CW_RSQ1); float* const RSQ2 = (float*)(F.ctl + CW_RSQ2);
    unsigned char* const G0 = (unsigned char*)F.out; unsigned char* const G1 = G0 + (size_t)NTOK * D;

    if (IN(0)) _Pragma("unroll") for (int rep_ = 0; rep_ < (MK_DUP == 0 ? 2 : 1); ++rep_) { p0_prologue(F); }
    SEAM(0);
#if MK_STAGE >= 9
#ifdef MK_PROBE_PH1NULL
    if (IN(1)) { pg8::Gemm g{H1, W_IN, NTOK, INW, D}; ORD_1 S; S.init(NTOK, INW, F.G, (int)blockIdx.x);
        pg8::EpiNull E{MRG}; pg8::gemm_phase<pg8::EpiNull, ORD_1, PG_ALIGN, PG_SP2>(F.lds + RING_OFF, g, S, E); }
#endif
#ifdef MK_STAG1
    if (IN(1) && (int)blockIdx.x >= 128) { const unsigned long long t0 = __builtin_amdgcn_s_memrealtime();
        while (__builtin_amdgcn_s_memrealtime() - t0 < (unsigned long long)MK_STAG1) __builtin_amdgcn_s_sleep(8); }
#endif
    if (IN(1)) _Pragma("unroll") for (int rep_ = 0; rep_ < (MK_DUP == 1 ? 2 : 1); ++rep_) {
        pg8::Gemm g{H1, W_IN, NTOK, INW, D}; ORD_1 S; S.init(NTOK, INW, F.G, (int)blockIdx.x);
        pg8::EpiZ E{QB, KB, VB, XR, YR, G0, G1, F.in[15]};
        pg8::gemm_phase<pg8::EpiZ, ORD_1, PG_ALIGN, PG_SP2>(F.lds + RING_OFF, g, S, E);
    }
    SEAM(1);
    if (IN(2)) {
#ifndef NO_ROPE
        qk_norm_rope(F, QB, KB);
#endif
#ifndef NO_LRU1
        lru_phase<false>(F, XR, YR, nullptr);
        if (MK_DUP == 20) lru_phase<false>(F, XR, YR, nullptr);
#endif
    }
    SEAM(2);
    if (IN(3)) { lru_carry(F);
#ifndef NO_ATTN
        for (int rep_ = 0; rep_ < MK_REP30; ++rep_) attn_phase_all(F, (char*)lds + RING_OFF, QB, KB, VB, AR);
#endif
    }
    SEAM(3);
    if (IN(4)) {
#ifndef NO_LRU3
        lru_phase<true>(F, XR, YR, AR);
        if (MK_DUP == 40) lru_phase<true>(F, XR, YR, AR);
#endif
    }
    SEAM(4);
    if (IN(5)) _Pragma("unroll") for (int rep_ = 0; rep_ < (MK_DUP == 5 ? 2 : 1); ++rep_) {
        pg8::Gemm g{AR, W_CAT, NTOK, D, 2 * AW}; ORD_5 S; S.init(NTOK, D, F.G, (int)blockIdx.x);
        pg8::EpiMerge E{MRG, G0, G1, D};
        pg8::gemm_phase<pg8::EpiMerge, ORD_5, PG_ALIGN, PG_SP2>(F.lds + RING_OFF, g, S, E);
    }
    SEAM(5);
#ifdef MK_STAGGER6
    if (IN(6)) { const unsigned long long t0 = __builtin_amdgcn_s_memrealtime(), dl = (unsigned long long)(blockIdx.x / 8 % 4) * MK_STAGGER6;
        while (__builtin_amdgcn_s_memrealtime() - t0 < dl) __builtin_amdgcn_s_sleep(8); }
#endif
    if (IN(6)) _Pragma("unroll") for (int rep_ = 0; rep_ < (MK_DUP == 6 ? 2 : 1); ++rep_) {
        pg8::Gemm g{MRG, W_OUT, NTOK, D, D}; ORD_6 S; S.init(NTOK, D, F.G, (int)blockIdx.x);
        typedef pg8::EpiResF32<false, false, true, false> EpiX1; EpiX1 E{F.in[0], F.in[1], NTOK_P, nullptr, D, HM, rep_ ? (float*)(F.ws + WS_AGG) : RSQ1, nullptr, 0.f, 0.f, nullptr};
        pg8::gemm_phase<EpiX1, ORD_6, PG_ALIGN, PG_SP2>(F.lds + RING_OFF, g, S, E);
    }
    SEAM(6);
#ifdef MK_XBAR
    if (IN(6) && IN(7)) { for (int k_ = 0; k_ < MK_XBAR; ++k_) xcd_barrier(bar); }
#endif
#endif
#define MLP_UP(c) do { pg8::Gemm g{HM + (size_t)(c) * MLP_ROWS * D, W_UP, MLP_ROWS, FF, D}; ORD_UP S; S.init(MLP_ROWS, FF, F.G, (int)blockIdx.x); \
        pg8::EpiRelu2 E{HID, FF}; pg8::gemm_phase<pg8::EpiRelu2, ORD_UP, PG_ALIGN, PG_SP2>(F.lds + RING_OFF, g, S, E); } while (0)
#define MLP_DN(c) do { pg8::Gemm g{HID, W_DN, MLP_ROWS, D, FF}; ORD_DN S; S.init(MLP_ROWS, D, F.G, (int)blockIdx.x); float* o = F.out + (size_t)(c) * MLP_ROWS * D; \
        typedef pg8::EpiResF32<true, X2_F32, !X2_F32, true> EpiDn; EpiDn E{nullptr, nullptr, 0, o, D, HM + (size_t)(c) * MLP_ROWS * D, RSQ2 + (c) * MLP_ROWS, RSQ1 + (c) * MLP_ROWS, 1.0f / D, NORM_EPS, HM + (size_t)(c) * MLP_ROWS * D}; pg8::gemm_phase<EpiDn, ORD_DN, PG_ALIGN, PG_SP2>(F.lds + RING_OFF, g, S, E); } while (0)
#ifdef MK_PROBE_UPNULL
    if (IN(7)) { pg8::Gemm g{HM, W_UP, MLP_ROWS, FF, D}; ORD_UP S; S.init(MLP_ROWS, FF, F.G, (int)blockIdx.x);
        pg8::EpiNull E{MRG}; pg8::gemm_phase<pg8::EpiNull, ORD_UP, PG_ALIGN, PG_SP2>(F.lds + RING_OFF, g, S, E); }
#endif
#ifdef MK_PROBE_L2
#ifndef MK_PROBE_K
#define MK_PROBE_K 1024
#endif
    if (IN(7)) { pg8::Gemm g{HM, W_UP, 512, 512, MK_PROBE_K}; pg8::RepOrder S{MK_PROBE_L2, (int)(blockIdx.x & 1), (int)((blockIdx.x >> 1) & 1)};
#ifdef MK_PROBE_RELU
        pg8::EpiRelu2 E{W_IN, FF}; pg8::gemm_phase<pg8::EpiRelu2, pg8::RepOrder, true, true>(F.lds + RING_OFF, g, S, E); }
#else
        pg8::EpiNull E{MRG}; pg8::gemm_phase<pg8::EpiNull, pg8::RepOrder, true, true>(F.lds + RING_OFF, g, S, E); }
#endif
#endif
    if (IN(7)) _Pragma("unroll") for (int rep_ = 0; rep_ < (MK_DUP == 8 ? 2 : 1); ++rep_) MLP_UP(0);
    SEAM(7);
    if (IN(8)) MLP_DN(0);
    if (IN(8) && MK_DUP == 90) { pg8::Gemm g{HID, W_DN, MLP_ROWS, D, FF}; ORD_DN S; S.init(MLP_ROWS, D, F.G, (int)blockIdx.x); float* o = F.out;
        typedef pg8::EpiResF32<true, true, false, true> EpiDn; EpiDn E{nullptr, nullptr, 0, o, D, nullptr, (float*)(F.ws + WS_AGG), RSQ1, 1.0f / D, NORM_EPS, HM}; pg8::gemm_phase<EpiDn, ORD_DN, PG_ALIGN, PG_SP2>(F.lds + RING_OFF, g, S, E); }
    SEAM(8);
    if (IN(9)) MLP_UP(1);
    SEAM(9);
    if (IN(10)) MLP_DN(1);
    SEAM(10);
#if MLP_NCH == 3
    if (IN(11)) MLP_UP(2);
    SEAM(11);
    if (IN(12)) MLP_DN(2);
    SEAM(12);
#endif
    if (IN(NPH - 1) && X2_F32 && gw < NTOK) {
        f32x4 va[16], vb[16]; row_load(F.out + (size_t)gw * D, F.lane, va);
        for (int m = gw; m < NTOK; m += 2 * NGW) {
            const bool h1 = m + NGW < NTOK, h2 = m + 2 * NGW < NTOK;
            if (h1) row_load(F.out + (size_t)(m + NGW) * D, F.lane, vb);
            scale_store_f32(va, F.in[20], RSQ2[m], F.out + (size_t)m * D, F.lane);
            if (h2) row_load(F.out + (size_t)(m + 2 * NGW) * D, F.lane, va);
            if (h1) scale_store_f32(vb, F.in[20], RSQ2[m + NGW], F.out + (size_t)(m + NGW) * D, F.lane);
        }
    }
    if (IN(NPH - 1) && !X2_F32) {
        const int c8 = F.lane & 7, r8 = F.lane >> 3;
        for (int it = gw; it < (NTOK / 256) * (D / 64); it += NGW) {
            const int rt = it / (D / 64), kt = it % (D / 64), col = kt * 64 + 8 * c8;
            const f32x4 g0 = *(const GAS f32x4*)(F.in[20] + col), g1 = *(const GAS f32x4*)(F.in[20] + col + 4);
            const GAS v4u* src = (const GAS v4u*)(HM + (size_t)it * 16384) + F.lane;
#pragma unroll 1
            for (int i0 = 0; i0 < 32; i0 += 8) {
                v4u w[8]; float ss[8];
#pragma unroll
                for (int i = 0; i < 8; ++i) { w[i] = src[(i0 + i) * 64]; ss[i] = RSQ2[rt * 256 + 8 * (i0 + i) + r8]; }
#pragma unroll
                for (int i = 0; i < 8; ++i) { const float rs = 1.0f / sqrtf(ss[i] * (1.f / D) + NORM_EPS);
                    f32x4 a = {bflo(w[i].x), bfhi(w[i].x), bflo(w[i].y), bfhi(w[i].y)}, b = {bflo(w[i].z), bfhi(w[i].z), bflo(w[i].w), bfhi(w[i].w)};
                    GAS f32x4* dst = (GAS f32x4*)(F.out + (size_t)(rt * 256 + 8 * (i0 + i) + r8) * D + col);
                    dst[0] = a * rs * g0; dst[1] = b * rs * g1; }
            }
        }
    }
#undef IN
#undef SEAM
}

extern "C" void kernel_launch(void* const* d_in, const int* in_sizes, int n_in, void* d_out, int out_size, void* d_ws, size_t ws_size, hipStream_t stream) {
    static int grid = 0;
    if (grid == 0) {
        if (n_in != 21 || in_sizes[0] != NTOK_P * D || in_sizes[1] != NTOK_S * D || out_size != NTOK * D || ws_size < WS_END) {
            fprintf(stderr, "kernel_launch: shape / workspace mismatch (n_in %d, out %d, ws %zu, need %zu); nothing launched\n", n_in, out_size, ws_size, (size_t)WS_END); grid = -1; return; }
        int dev = 0, cus = 0, per_cu = 0;
        if (hipGetDevice(&dev) != hipSuccess || hipDeviceGetAttribute(&cus, hipDeviceAttributeMultiprocessorCount, dev) != hipSuccess) { grid = -1; return; }
        if (hipFuncSetAttribute((const void*)mk_fwd, hipFuncAttributeMaxDynamicSharedMemorySize, LDS_BYTES) != hipSuccess) { fprintf(stderr, "kernel_launch: hipFuncSetAttribute failed\n"); grid = -1; return; }
        if (hipOccupancyMaxActiveBlocksPerMultiprocessor(&per_cu, (const void*)mk_fwd, NWAVES * 64, LDS_BYTES) != hipSuccess || per_cu < 1) { fprintf(stderr, "kernel_launch: occupancy query says %d blocks per CU\n", per_cu); grid = -1; return; }
        (void)hipGetLastError();
        grid = cus;
    }
    if (grid < 0) return;
    if (hipMemsetAsync((char*)d_ws + WS_CTL, 0, CTL_ZERO_BYTES, stream) != hipSuccess) return;
    Args a{};
    for (int i = 0; i < 21; ++i) a.in[i] = (const float*)d_in[i];
    a.out = (float*)d_out; a.ws = (unsigned char*)d_ws;
#if MK_PER_PHASE
    for (int p = 0; p < NPH; ++p) { a.ph_lo = p; a.ph_hi = p + 1; hipLaunchKernelGGL(mk_fwd, dim3(grid), dim3(NWAVES * 64), LDS_BYTES, stream, a); }
#else
    a.ph_lo = 0; a.ph_hi = NPH; hipLaunchKernelGGL(mk_fwd, dim3(grid), dim3(NWAVES * 64), LDS_BYTES, stream, a);
#endif
    const hipError_t le = hipPeekAtLastError();
    if (le != hipSuccess) fprintf(stderr, "kernel_launch: launch failed: %s\n", hipGetErrorName(le));
}
```

```cpp
#include <hip/hip_runtime.h>
#include <hip/hip_bf16.h>
#include <cstdio>
#include <cstdint>
namespace pg8 {
#define PG8_LAS __attribute__((address_space(3)))
typedef unsigned short bf16_t;
typedef short bf16x8 __attribute__((ext_vector_type(8)));
typedef float f32x4 __attribute__((ext_vector_type(4)));
typedef unsigned u32x4 __attribute__((ext_vector_type(4)));
constexpr int BM = 256, BK = 64, HALF = 128, HTB = HALF * BK * 2  , STAGE_BYTES = 8 * HTB, NXCD = 8, WGM = 8;

__host__ __device__ __forceinline__ int lds_byte(int r, int c) { const int st = (r >> 4) * 2 + (c >> 5), rr = r & 15, cc = c & 31, ob = rr * 64 + cc * 2; return st * 1024 + (ob ^ (((ob >> 9) & 1) << 5)); }
__host__ __device__ __forceinline__ void stage_rc(int b, int& R, int& C) { const int st = b / 1024, sb = b % 1024, swz = sb ^ (((sb >> 9) & 1) << 5); R = (st >> 1) * 16 + swz / 64; C = (st & 1) * 32 + (swz % 64) / 2; }
__host__ __device__ __forceinline__ int perm32(int rho) { const int n = rho >> 4, i = rho & 15; return 8 * (i >> 2) + 4 * n + (i & 3); }

#ifndef PG8_TILED
#define PG8_TILED 1
#endif
__host__ __device__ __forceinline__ size_t toff(int row, int col, int Kd) {
#if PG8_TILED
    return ((size_t)((row >> 8) * (Kd >> 6) + (col >> 6)) << 14) + (size_t)(((row & 255) << 6) + (col & 63));
#else
    return (size_t)row * Kd + col;
#endif
}
struct Unit { int pm, pn; };
struct Gemm { const bf16_t* A; const bf16_t* Bt; int M, N, K; };

struct StaticOrder {
    int nM, nN, nwg, G, c, wgm;
    __host__ __device__ void init(int M, int N, int G_, int c_, int wgm_ = WGM) { nM = M / BM; nN = N / BM; nwg = nM * nN; G = G_; c = c_; wgm = wgm_; }
    __host__ __device__ bool next(int i, Unit& u) const { const long L = (long)i * G + c; if (L >= nwg) return false; map((int)L, u); return true; }
    __host__ __device__ void map(int L, Unit& u) const {
        int wgid = L; { const int q = nwg / NXCD, r = nwg % NXCD, xcd = wgid % NXCD, off = wgid / NXCD; wgid = (xcd < r ? xcd * (q + 1) : r * (q + 1) + (xcd - r) * q) + off; }
        const int nig = wgm * nN, gid = wgid / nig, fm = gid * wgm, gsz = (nM - fm) < wgm ? (nM - fm) : wgm;
        u.pm = fm + ((wgid % nig) % gsz); u.pn = (wgid % nig) / gsz;
    }
    __device__ __forceinline__ void a_ready(const Unit&) const {}
    __device__ __forceinline__ void done(const Unit&) const {}
};

__device__ __forceinline__ unsigned cvt_pk_bf16(float lo, float hi) { unsigned r; asm volatile("v_cvt_pk_bf16_f32 %0, %1, %2" : "=v"(r) : "v"(lo), "v"(hi)); return r; }
typedef float f32x2 __attribute__((ext_vector_type(2)));
__device__ __forceinline__ f32x2 gelu_pk(f32x2 v) {
    const f32x2 av = __builtin_elementwise_abs(v), d = av * 0.2316418882f + 1.0f;
    f32x2 t; t.x = __builtin_amdgcn_rcpf(d.x); t.y = __builtin_amdgcn_rcpf(d.y);
    f32x2 q = t * 0.5307027145f + (-0.7265760135f); q = q * t + 0.7107068705f; q = q * t + (-0.142248368f); q = q * t + 0.127414796f; q = q * t;
    const f32x2 s = (v * v) * (-0.72134752044f);
    f32x2 e; e.x = __builtin_amdgcn_exp2f(s.x); e.y = __builtin_amdgcn_exp2f(s.y);
    const f32x2 m = v * (q * e), r = v - m;
    f32x2 o; o.x = v.x < 0.f ? m.x : r.x; o.y = v.y < 0.f ? m.y : r.y; return o;
}

#ifdef EPI_NT
#define EPI_ST16(p, v) __builtin_nontemporal_store((v), (p))
#else
#define EPI_ST16(p, v) (*(p) = (v))
#endif
#ifndef DN_AB
#define DN_AB 1
#endif
#ifndef MID_MB
#define MID_MB 2
#endif
#ifndef EPI_MB
#define EPI_MB 4
#endif
__device__ __forceinline__ float bf_lo(unsigned w) { return __uint_as_float(w << 16); }
__device__ __forceinline__ float bf_hi(unsigned w) { return __uint_as_float(w & 0xffff0000u); }
__device__ __forceinline__ float sigmoid_f(float x) { return __builtin_amdgcn_rcpf(1.0f + __builtin_amdgcn_exp2f(-1.4426950408889634f * x)); }

struct EpiZ {
    static constexpr bool PERM = true, AFTER_DRAIN = false, MID = false;
    bf16_t *Q, *Kb, *V, *XR, *YR; unsigned char *G0, *G1; const float* b_gate; const float* rs0;
    __device__ __forceinline__ void operator()(const f32x4 (&acc)[2][2][4][2], const Unit& u, int wr, int wc, int fr, int fq) const {
        asm volatile("" : "+v"(fr), "+v"(fq));
        const int pn = u.pn; bf16_t* base; unsigned char* gb = nullptr; int ldc, colt; const float* bias = nullptr;
        if (pn < 8)       { base = Q;  ldc = 2048; colt = pn * BM; }
        else if (pn < 10) { base = Kb; ldc = 512;  colt = (pn - 8) * BM; }
        else if (pn < 12) { base = V;  ldc = 512;  colt = (pn - 10) * BM; }
        else if (pn < 20) { base = XR; ldc = 2048; colt = (pn - 12) * BM; }
        else if (pn < 28) { base = YR; ldc = 2048; colt = (pn - 20) * BM; }
        else if (pn < 44) { base = Q; gb = G0; ldc = 4096; colt = (pn - 28) * BM; bias = b_gate + colt; }
        else              { base = Q; gb = G1; ldc = 4096; colt = (pn - 44) * BM; bias = b_gate + 4096 + colt; }
        const int row0 = u.pm * BM + wr * 64 + fr, col0 = colt + wc * 32 + 8 * fq, bc0 = wc * 32 + 8 * fq;
        const bool gate = bias != nullptr;
        float rsv[2][4];
#pragma unroll
        for (int ai = 0; ai < 2; ++ai)
#pragma unroll
            for (int m = 0; m < 4; ++m) rsv[ai][m] = rs0[row0 + ai * HALF + m * 16] * (gate ? -1.4426950408889634f : 1.0f);
        f32x4 bv[2][2];
#pragma unroll
        for (int bj = 0; bj < 2; ++bj)
#pragma unroll
            for (int n = 0; n < 2; ++n) bv[bj][n] = gate ? *(const f32x4*)(bias + bc0 + bj * HALF + 4 * n) * -1.4426950408889634f : (f32x4){0.f, 0.f, 0.f, 0.f};
#pragma unroll
        for (int ai = 0; ai < 2; ++ai)
#pragma unroll
            for (int m = 0; m < 4; ++m) { bf16_t* rowp = base + (size_t)(row0 + ai * HALF + m * 16) * ldc + col0;
#pragma unroll
                for (int bj = 0; bj < 2; ++bj) { f32x4 v0 = acc[ai][bj][m][0] * rsv[ai][m], v1 = acc[ai][bj][m][1] * rsv[ai][m];
                    if (gate) { unsigned lo = 0u, hi = 0u;
#pragma unroll
                        for (int e = 0; e < 4; ++e) {
                            const float t0 = fmaf(acc[ai][bj][m][0][e], rsv[ai][m], bv[bj][0][e]), t1 = fmaf(acc[ai][bj][m][1][e], rsv[ai][m], bv[bj][1][e]);
                            const float q0 = __builtin_amdgcn_rcpf(fmaf(__builtin_amdgcn_exp2f(t0), 1.0f / 255.f, 1.0f / 255.f)), q1 = __builtin_amdgcn_rcpf(fmaf(__builtin_amdgcn_exp2f(t1), 1.0f / 255.f, 1.0f / 255.f));
                            lo |= (unsigned)(q0 + 0.5f) << (8 * e); hi |= (unsigned)(q1 + 0.5f) << (8 * e); }
                        typedef unsigned u32x2 __attribute__((ext_vector_type(2)));
                        *(u32x2*)(gb + (size_t)(row0 + ai * HALF + m * 16) * ldc + col0 + bj * HALF) = (u32x2){lo, hi}; continue; }
                    u32x4 w; w.x = cvt_pk_bf16(v0[0], v0[1]); w.y = cvt_pk_bf16(v0[2], v0[3]); w.z = cvt_pk_bf16(v1[0], v1[1]); w.w = cvt_pk_bf16(v1[2], v1[3]);
                    EPI_ST16((u32x4*)(rowp + bj * HALF), w); } }
    }
};

struct EpiMerge {
    struct MidState { unsigned g1[2][4][2][2]; };
    static __device__ __forceinline__ float gq(unsigned w, int e) { return fmaxf((float)((w >> (8 * e)) & 0xffu), 0.5f); }
    static constexpr bool PERM = true, AFTER_DRAIN = false, MID = true;
    bf16_t* O; const unsigned char* G0; const unsigned char* G1; int ldc;
    __device__ __forceinline__ void mid(f32x4 (&acc)[2][2][4][2], MidState& ms, const Unit& u, int wr, int wc, int fr, int fq) const {
        asm volatile("" : "+v"(fr), "+v"(fq));
        typedef unsigned u32x2 __attribute__((ext_vector_type(2)));
        const int row0 = u.pm * BM + wr * 64 + fr, col0 = u.pn * BM + wc * 32 + 8 * fq;
        u32x2 g[2][4][2];
#pragma unroll
        for (int ai = 0; ai < 2; ++ai)
#pragma unroll
            for (int m = 0; m < 4; ++m) { const size_t off = (size_t)(row0 + ai * HALF + m * 16) * ldc + col0;
#pragma unroll
                for (int bj = 0; bj < 2; ++bj) { g[ai][m][bj] = *(const u32x2*)(G0 + off + bj * HALF); const u32x2 h = *(const u32x2*)(G1 + off + bj * HALF); ms.g1[ai][m][bj][0] = h.x; ms.g1[ai][m][bj][1] = h.y; } }
#pragma unroll
        for (int ai = 0; ai < 2; ++ai)
#pragma unroll
            for (int m = 0; m < 4; ++m)
#pragma unroll
                for (int bj = 0; bj < 2; ++bj) { f32x4& v0 = acc[ai][bj][m][0]; f32x4& v1 = acc[ai][bj][m][1];
#pragma unroll
                    for (int e = 0; e < 4; ++e) { v0[e] *= gq(g[ai][m][bj].x, e) * __builtin_amdgcn_rcpf(gq(ms.g1[ai][m][bj][0], e)); v1[e] *= gq(g[ai][m][bj].y, e) * __builtin_amdgcn_rcpf(gq(ms.g1[ai][m][bj][1], e)); } }
    }
    __device__ __forceinline__ void operator()(const f32x4 (&acc)[2][2][4][2], const MidState& ms, const Unit& u, int wr, int wc, int fr, int fq) const {
        asm volatile("" : "+v"(fr), "+v"(fq));
        const int row0 = u.pm * BM + wr * 64 + fr, col0 = u.pn * BM + wc * 32 + 8 * fq;
#pragma unroll
        for (int ai = 0; ai < 2; ++ai)
#pragma unroll
            for (int m = 0; m < 4; ++m)
#pragma unroll
                for (int bj = 0; bj < 2; ++bj) { const f32x4 v0 = acc[ai][bj][m][0], v1 = acc[ai][bj][m][1]; const unsigned h0 = ms.g1[ai][m][bj][0], h1 = ms.g1[ai][m][bj][1]; constexpr float s = 1.0f / 255.0f; u32x4 w;
                    w.x = cvt_pk_bf16(gq(h0, 0) * s * v0[0], gq(h0, 1) * s * v0[1]); w.y = cvt_pk_bf16(gq(h0, 2) * s * v0[2], gq(h0, 3) * s * v0[3]);
                    w.z = cvt_pk_bf16(gq(h1, 0) * s * v1[0], gq(h1, 1) * s * v1[1]); w.w = cvt_pk_bf16(gq(h1, 2) * s * v1[2], gq(h1, 3) * s * v1[3]);
                    *(u32x4*)(O + toff(row0 + ai * HALF + m * 16, col0 + bj * HALF, ldc)) = w; }
    }
};

template <bool BASE_BF16, bool STORE_F32, bool STORE_BF16, bool RSCALE> struct EpiResF32 {
    static constexpr bool PERM = false, AFTER_DRAIN = false, MID = false;
    const float* B0; const float* B1; int split; float* out; int ldc; bf16_t* XB; float* rowsq; const float* rsq_in; float inv_k, eps; const bf16_t* BB;
    __device__ __forceinline__ void operator()(const f32x4 (&acc)[2][2][4][2], const Unit& u, int wr, int wc, int fr, int fq) const {
        asm volatile("" : "+v"(fr), "+v"(fq));
        const int rt0 = u.pm * BM; const float* bs = rt0 < split ? B0 + (size_t)rt0 * ldc : B1 + (size_t)(rt0 - split) * ldc; float* ob = out + (size_t)rt0 * ldc;
        const int col0 = u.pn * BM + wc * 32 + 4 * fq;
#pragma unroll
        for (int ai = 0; ai < 2; ++ai)
#pragma unroll
        for (int m0 = 0; m0 < 4; m0 += EPI_MB) {
            f32x4 b[4][2][2]; float sc[4];
#pragma unroll
            for (int m = m0; m < m0 + EPI_MB; ++m) sc[m] = RSCALE ? rsq_in[rt0 + wr * 64 + fr + ai * HALF + m * 16] : 0.f;
#pragma unroll
            for (int m = m0; m < m0 + EPI_MB; ++m) { const size_t off = (size_t)(wr * 64 + fr + ai * HALF + m * 16) * ldc + col0;
#pragma unroll
                for (int bj = 0; bj < 2; ++bj)
#pragma unroll
                    for (int n = 0; n < 2; ++n) {
                        if (BASE_BF16) { typedef unsigned u32x2 __attribute__((ext_vector_type(2))); const u32x2 w = *(const u32x2*)(BB + toff(rt0 + wr * 64 + fr + ai * HALF + m * 16, col0 + bj * HALF + n * 16, ldc));
                            b[m][bj][n] = (f32x4){bf_lo(w.x), bf_hi(w.x), bf_lo(w.y), bf_hi(w.y)}; }
                        else b[m][bj][n] = *(const f32x4*)(bs + off + bj * HALF + n * 16); } }
#pragma unroll
            for (int m = m0; m < m0 + EPI_MB; ++m) { const int rloc = wr * 64 + fr + ai * HALF + m * 16; const size_t off = (size_t)rloc * ldc + col0; float sq = 0.f; const float r2 = RSCALE ? __builtin_amdgcn_rcpf(sc[m] * inv_k + eps) : 1.0f;
#pragma unroll
                for (int bj = 0; bj < 2; ++bj)
#pragma unroll
                    for (int n = 0; n < 2; ++n) { const f32x4 o = b[m][bj][n] + acc[ai][bj][m][n] * r2; if (STORE_F32) *(f32x4*)(ob + off + bj * HALF + n * 16) = o;
                        sq += (o[0] * o[0] + o[1] * o[1]) + (o[2] * o[2] + o[3] * o[3]);
                        if (STORE_BF16) { typedef unsigned u32x2 __attribute__((ext_vector_type(2))); u32x2 w; w.x = cvt_pk_bf16(o[0], o[1]); w.y = cvt_pk_bf16(o[2], o[3]);
                            *(u32x2*)(XB + toff(rt0 + rloc, col0 + bj * HALF + n * 16, ldc)) = w; } }
                sq += __shfl_xor(sq, 16); sq += __shfl_xor(sq, 32);
#ifndef NO_ATOM
#ifdef MK_ATOM2
                if (fq == 0) { __hip_atomic_fetch_add(rowsq + rt0 + rloc, 0.5f * sq, __ATOMIC_RELAXED, __HIP_MEMORY_SCOPE_AGENT); __hip_atomic_fetch_add(rowsq + rt0 + rloc, 0.5f * sq, __ATOMIC_RELAXED, __HIP_MEMORY_SCOPE_AGENT); }
#else
                if (fq == 0) __hip_atomic_fetch_add(rowsq + rt0 + rloc, sq, __ATOMIC_RELAXED, __HIP_MEMORY_SCOPE_AGENT);
#endif
#endif
                }
        }
    }
};

struct EpiX1P {
    static constexpr bool PERM = true, AFTER_DRAIN = false, MID = false;
    const float* B0; const float* B1; int split; int ldc; bf16_t* XB; float* rowsq;
    __device__ __forceinline__ void operator()(const f32x4 (&acc)[2][2][4][2], const Unit& u, int wr, int wc, int fr, int fq) const {
        asm volatile("" : "+v"(fr), "+v"(fq));
        const int rt0 = u.pm * BM; const float* bs = rt0 < split ? B0 + (size_t)rt0 * ldc : B1 + (size_t)(rt0 - split) * ldc;
        const int col0 = u.pn * BM + wc * 32 + 8 * fq;
#pragma unroll
        for (int ai = 0; ai < 2; ++ai) {
            f32x4 b[4][2][2];
#pragma unroll
            for (int m = 0; m < 4; ++m) { const size_t off = (size_t)(wr * 64 + fr + ai * HALF + m * 16) * ldc + col0;
#pragma unroll
                for (int bj = 0; bj < 2; ++bj) { b[m][bj][0] = *(const f32x4*)(bs + off + bj * HALF); b[m][bj][1] = *(const f32x4*)(bs + off + bj * HALF + 4); } }
#pragma unroll
            for (int m = 0; m < 4; ++m) { const int rloc = wr * 64 + fr + ai * HALF + m * 16; float sq = 0.f;
#pragma unroll
                for (int bj = 0; bj < 2; ++bj) { const f32x4 o0 = b[m][bj][0] + acc[ai][bj][m][0], o1 = b[m][bj][1] + acc[ai][bj][m][1];
                    sq += ((o0[0] * o0[0] + o0[1] * o0[1]) + (o0[2] * o0[2] + o0[3] * o0[3])) + ((o1[0] * o1[0] + o1[1] * o1[1]) + (o1[2] * o1[2] + o1[3] * o1[3]));
                    u32x4 w; w.x = cvt_pk_bf16(o0[0], o0[1]); w.y = cvt_pk_bf16(o0[2], o0[3]); w.z = cvt_pk_bf16(o1[0], o1[1]); w.w = cvt_pk_bf16(o1[2], o1[3]);
                    *(u32x4*)(XB + toff(rt0 + rloc, col0 + bj * HALF, ldc)) = w; }
                sq += __shfl_xor(sq, 16); sq += __shfl_xor(sq, 32);
                if (fq == 0) __hip_atomic_fetch_add(rowsq + rt0 + rloc, sq, __ATOMIC_RELAXED, __HIP_MEMORY_SCOPE_AGENT); }
        }
    }
};
struct EpiDnP {
    static constexpr bool PERM = true, AFTER_DRAIN = false, MID = false;
    int ldc; bf16_t* XB; float* rowsq; const float* rsq_in; float inv_k, eps;
    __device__ __forceinline__ void operator()(const f32x4 (&acc)[2][2][4][2], const Unit& u, int wr, int wc, int fr, int fq) const {
        asm volatile("" : "+v"(fr), "+v"(fq));
        const int rt0 = u.pm * BM, col0 = u.pn * BM + wc * 32 + 8 * fq;
#pragma unroll
        for (int a0 = 0; a0 < 2; a0 += DN_AB) {
        u32x4 b[2][4][2]; float sc[2][4];
#pragma unroll
        for (int ai = a0; ai < a0 + DN_AB; ++ai)
#pragma unroll
            for (int m = 0; m < 4; ++m) { const int row = rt0 + wr * 64 + fr + ai * HALF + m * 16; sc[ai][m] = rsq_in[row];
#pragma unroll
                for (int bj = 0; bj < 2; ++bj) b[ai][m][bj] = *(const u32x4*)(XB + toff(row, col0 + bj * HALF, ldc)); }
#pragma unroll
        for (int ai = a0; ai < a0 + DN_AB; ++ai)
#pragma unroll
            for (int m = 0; m < 4; ++m) { const int row = rt0 + wr * 64 + fr + ai * HALF + m * 16; float sq = 0.f; const float r2 = __builtin_amdgcn_rcpf(sc[ai][m] * inv_k + eps);
#pragma unroll
                for (int bj = 0; bj < 2; ++bj) { const u32x4 x = b[ai][m][bj]; const f32x4 a0 = acc[ai][bj][m][0], a1 = acc[ai][bj][m][1];
                    const f32x4 o0 = (f32x4){bf_lo(x.x), bf_hi(x.x), bf_lo(x.y), bf_hi(x.y)} + a0 * r2, o1 = (f32x4){bf_lo(x.z), bf_hi(x.z), bf_lo(x.w), bf_hi(x.w)} + a1 * r2;
                    sq += ((o0[0] * o0[0] + o0[1] * o0[1]) + (o0[2] * o0[2] + o0[3] * o0[3])) + ((o1[0] * o1[0] + o1[1] * o1[1]) + (o1[2] * o1[2] + o1[3] * o1[3]));
                    u32x4 w; w.x = cvt_pk_bf16(o0[0], o0[1]); w.y = cvt_pk_bf16(o0[2], o0[3]); w.z = cvt_pk_bf16(o1[0], o1[1]); w.w = cvt_pk_bf16(o1[2], o1[3]);
                    *(u32x4*)(XB + toff(row, col0 + bj * HALF, ldc)) = w; }
                sq += __shfl_xor(sq, 16); sq += __shfl_xor(sq, 32);
                if (fq == 0) __hip_atomic_fetch_add(rowsq + row, sq, __ATOMIC_RELAXED, __HIP_MEMORY_SCOPE_AGENT); }
        }
    }
};

template <bool RSCALE> struct EpiResP {
    static constexpr bool PERM = true, AFTER_DRAIN = false, MID = false;
    int ldc; const bf16_t* BB; bf16_t* XB; float* rowsq; const float* rsq_in; float inv_k, eps;
    __device__ __forceinline__ void operator()(const f32x4 (&acc)[2][2][4][2], const Unit& u, int wr, int wc, int fr, int fq) const {
        asm volatile("" : "+v"(fr), "+v"(fq));
        const int rt0 = u.pm * BM, col0 = u.pn * BM + wc * 32 + 8 * fq;
#pragma unroll
        for (int ai = 0; ai < 2; ++ai) {
            u32x4 b[4][2]; float sc[4];
#pragma unroll
            for (int m = 0; m < 4; ++m) { const int row = rt0 + wr * 64 + fr + ai * HALF + m * 16; sc[m] = RSCALE ? rsq_in[row] : 0.f;
#pragma unroll
                for (int bj = 0; bj < 2; ++bj) b[m][bj] = *(const u32x4*)(BB + toff(row, col0 + bj * HALF, ldc)); }
#pragma unroll
            for (int m = 0; m < 4; ++m) { const int row = rt0 + wr * 64 + fr + ai * HALF + m * 16; float sq = 0.f; const float r2 = RSCALE ? __builtin_amdgcn_rcpf(sc[m] * inv_k + eps) : 1.0f;
#pragma unroll
                for (int bj = 0; bj < 2; ++bj) { const u32x4 x = b[m][bj]; const f32x4 a0 = acc[ai][bj][m][0], a1 = acc[ai][bj][m][1];
                    const f32x4 o0 = (f32x4){bf_lo(x.x), bf_hi(x.x), bf_lo(x.y), bf_hi(x.y)} + a0 * r2, o1 = (f32x4){bf_lo(x.z), bf_hi(x.z), bf_lo(x.w), bf_hi(x.w)} + a1 * r2;
                    sq += ((o0[0] * o0[0] + o0[1] * o0[1]) + (o0[2] * o0[2] + o0[3] * o0[3])) + ((o1[0] * o1[0] + o1[1] * o1[1]) + (o1[2] * o1[2] + o1[3] * o1[3]));
                    u32x4 w; w.x = cvt_pk_bf16(o0[0], o0[1]); w.y = cvt_pk_bf16(o0[2], o0[3]); w.z = cvt_pk_bf16(o1[0], o1[1]); w.w = cvt_pk_bf16(o1[2], o1[3]);
                    *(u32x4*)(XB + toff(row, col0 + bj * HALF, ldc)) = w; }
                sq += __shfl_xor(sq, 16); sq += __shfl_xor(sq, 32);
                if (fq == 0) __hip_atomic_fetch_add(rowsq + row, sq, __ATOMIC_RELAXED, __HIP_MEMORY_SCOPE_AGENT); }
        }
    }
};

struct EpiRelu2 {
    static constexpr bool PERM = true, AFTER_DRAIN = false, MID = false;
    bf16_t* O; int ldc;
    __device__ __forceinline__ void operator()(const f32x4 (&acc)[2][2][4][2], const Unit& u, int wr, int wc, int fr, int fq) const {
        asm volatile("" : "+v"(fr), "+v"(fq));
        const int row0 = u.pm * BM + wr * 64 + fr, col0 = u.pn * BM + wc * 32 + 8 * fq;
#pragma unroll
        for (int ai = 0; ai < 2; ++ai)
#pragma unroll
            for (int m = 0; m < 4; ++m) { bf16_t* rowp = O + (size_t)(row0 + ai * HALF + m * 16) * ldc + col0;
#pragma unroll
                for (int bj = 0; bj < 2; ++bj) { f32x4 v0 = acc[ai][bj][m][0], v1 = acc[ai][bj][m][1];
#pragma unroll
                    for (int e = 0; e < 4; ++e) { const float a = fmaxf(v0[e], 0.f), b = fmaxf(v1[e], 0.f); v0[e] = a * a; v1[e] = b * b; }
                    u32x4 w; w.x = cvt_pk_bf16(v0[0], v0[1]); w.y = cvt_pk_bf16(v0[2], v0[3]); w.z = cvt_pk_bf16(v1[0], v1[1]); w.w = cvt_pk_bf16(v1[2], v1[3]);
                    EPI_ST16((u32x4*)(O + toff(row0 + ai * HALF + m * 16, col0 + bj * HALF, ldc)), w); } }
    }
};
struct EpiNull {
    static constexpr bool PERM = true, AFTER_DRAIN = false, MID = false;
    bf16_t* O;
    __device__ __forceinline__ void operator()(const f32x4 (&acc)[2][2][4][2], const Unit& u, int wr, int wc, int fr, int fq) const {
        asm volatile("" : "+v"(fr), "+v"(fq));
        float s = 0.f;
#pragma unroll
        for (int ai = 0; ai < 2; ++ai)
#pragma unroll
            for (int bj = 0; bj < 2; ++bj)
#pragma unroll
                for (int m = 0; m < 4; ++m)
#pragma unroll
                    for (int n = 0; n < 2; ++n) s += (acc[ai][bj][m][n][0] + acc[ai][bj][m][n][1]) + (acc[ai][bj][m][n][2] + acc[ai][bj][m][n][3]);
        if (s == 123456.789f) O[(wr * 4 + wc) * 64 + fr + 16 * fq] = 1;
    }
};
struct RepOrder {
    int n, pm, pn;
    __device__ bool next(int i, Unit& u) const { if (i >= n) return false; u.pm = pm; u.pn = pn; return true; }
    __device__ __forceinline__ void a_ready(const Unit&) const {}
    __device__ __forceinline__ void done(const Unit&) const {}
};

struct SharedOrder {
    StaticOrder so; bool shared; int x, r, SC, q;
    __device__ void init(int M, int N, int G_, int c_) { so.init(M, N, G_, c_); shared = (G_ == 256) && (so.nM % 16 == 0) && (so.nN % 4 == 0); x = c_ & 7; r = c_ >> 3; SC = so.nN / 4; q = so.nwg / 8; }
    __device__ bool next(int i, Unit& u) const {
        if (!shared) return so.next(i, u);
        const int idx = i * 32 + r; if (idx >= q) return false;
        const int bs = 8 * SC, blk = idx / bs, rem = idx - blk * bs;
        u.pm = (2 * blk + (x >> 2)) * 8 + (rem & 7); u.pn = (x & 3) * SC + (rem >> 3); return true;
    }
    __device__ __forceinline__ void a_ready(const Unit&) const {}
    __device__ __forceinline__ void done(const Unit&) const {}
};

template <class Base> struct RevCols {
    Base b;
    __device__ void init(int M, int N, int G_, int c_) { b.init(M, N, G_, c_); }
    __device__ bool next(int i, Unit& u) const { if (!b.next(i, u)) return false; u.pn = N_tiles() - 1 - u.pn; return true; }
    __device__ __forceinline__ int N_tiles() const { return b.nN; }
    __device__ __forceinline__ void a_ready(const Unit&) const {}
    __device__ __forceinline__ void done(const Unit&) const {}
};

template <int NPART> struct SplitOrder {
    StaticOrder so; int G, c, part_nwg, part_nM;
    __device__ void init(int M, int N, int G_, int c_) { so.init(M / NPART, N, G_, c_); G = G_; c = c_; part_nwg = so.nwg; part_nM = so.nM; }
    __device__ bool next(int i, Unit& u) const {
        const long L = (long)i * G + c; if (L >= (long)NPART * part_nwg) return false;
        const int part = (int)(L / part_nwg); so.map((int)(L - (long)part * part_nwg), u); u.pm += part * part_nM; return true;
    }
    __device__ __forceinline__ void a_ready(const Unit&) const {}
    __device__ __forceinline__ void done(const Unit&) const {}
};

template <int N1T> struct ColSplitOrder {
    StaticOrder s1, s2; int G, c;
    __device__ void init(int M, int N, int G_, int c_) { s1.init(M, N1T * BM, G_, c_); s2.init(M, N - N1T * BM, G_, c_); G = G_; c = c_; }
    __device__ bool next(int i, Unit& u) const {
        const long L = (long)i * G + c; if (L >= (long)s1.nwg + s2.nwg) return false;
        if (L < s1.nwg) s1.map((int)L, u); else { s2.map((int)(L - s1.nwg), u); u.pn += N1T; }
        return true;
    }
    __device__ __forceinline__ void a_ready(const Unit&) const {}
    __device__ __forceinline__ void done(const Unit&) const {}
};

template <int B1, int B2, int B3> struct ColSplit4 {
    int M, nN, G, c;
    __device__ void init(int M_, int N, int G_, int c_) { M = M_; nN = N / BM; G = G_; c = c_; }
    __device__ bool next(int i, Unit& u) const {
        long L = (long)i * G + c; const int nM = M / BM; int b0 = 0;
#pragma unroll
        for (int p = 0; p < 4; ++p) { const int b1 = p == 0 ? B1 : p == 1 ? B2 : p == 2 ? B3 : nN; const long n = (long)nM * (b1 - b0);
            if (L < n) { StaticOrder so; so.init(M, (b1 - b0) * BM, G, c); so.map((int)L, u); u.pn += b0; return true; }
            L -= n; b0 = b1; }
        return false;
    }
    __device__ __forceinline__ void a_ready(const Unit&) const {}
    __device__ __forceinline__ void done(const Unit&) const {}
};

struct ColSharedOrder {
    StaticOrder so; bool on; int x, r;
    __device__ void init(int M, int N, int G_, int c_) { so.init(M, N, G_, c_); on = (G_ == 256) && (so.nM == 96) && (so.nN == 60); x = c_ & 7; r = c_ >> 3; }
    __device__ bool next(int i, Unit& u) const {
        if (!on) return so.next(i, u);
        const int idx = i * 32 + r; if (idx >= 720) return false;
        const int part = idx < 576 ? idx / 192 : 3, rem = idx - part * 192, SC = part < 3 ? 4 : 3, bs = 8 * SC, blk = rem / bs, t = rem - blk * bs;
        u.pm = (2 * blk + (x >> 2)) * 8 + (t & 7); u.pn = part * 16 + (x & 3) * SC + (t >> 3); return true;
    }
    __device__ __forceinline__ void a_ready(const Unit&) const {}
    __device__ __forceinline__ void done(const Unit&) const {}
};
template <class E, bool M> struct MidT { struct type {}; };
template <class E> struct MidT<E, true> { typedef typename E::MidState type; };
template <class Epi, class Sched, bool ALIGN_EPI = false, bool SP2 = false>
__device__ __forceinline__ void gemm_phase(PG8_LAS unsigned char* lds, const Gemm g, const Sched& S, const Epi& E) {
    const int tid = threadIdx.x, wid = __builtin_amdgcn_readfirstlane(tid >> 6), lane = tid & 63, wr = wid >> 2, wc = wid & 3, fr = lane & 15, fq = lane >> 4;
    const int K = g.K, nt = K / BK;
    unsigned voffA[2], voffB[2];
#pragma unroll
    for (int i = 0; i < 2; ++i) { int R, C; stage_rc(tid * 16 + i * 8192, R, C); const int Rb = Epi::PERM ? ((R & ~31) + perm32(R & 31)) : R;
#if PG8_TILED
        voffA[i] = (unsigned)(R * BK + C) * 2u; voffB[i] = (unsigned)(Rb * BK + C) * 2u; }
    const size_t kstep = (size_t)BM * BK * 2;
    const size_t hstep = (size_t)HALF * BK * 2;
    const size_t tstep = (size_t)BM * K * 2;
#else
        voffA[i] = (unsigned)(R * K + C) * 2u; voffB[i] = (unsigned)(Rb * K + C) * 2u; }
    const size_t kstep = (size_t)(BK * 2);
    const size_t hstep = (size_t)HALF * K * 2;
    const size_t tstep = 2 * hstep;
#endif
    const unsigned ldsw = (unsigned)wid * 1024u;
    const int aoff = lds_byte(wr * 64 + fr, fq * 8), boff = lds_byte(wc * 32 + fr, fq * 8);
#define PG8_SA(b, h) (((b) * 2 + (h)) * HTB)
#define PG8_SB(b, h) ((4 + (b) * 2 + (h)) * HTB)
#ifndef PG8_AUX
#define PG8_AUX 0
#endif
#define PG8_STAGE(bufoff, gbase, voff) do { _Pragma("unroll") for (int _i = 0; _i < 2; ++_i) \
        __builtin_amdgcn_global_load_lds((const unsigned*)((const char*)(gbase) + (voff)[_i]), (PG8_LAS unsigned*)(lds + (bufoff) + ldsw + _i * 8192), 16, 0, PG8_AUX); } while (0)
#define PG8_LDA(dst, b, h) do { _Pragma("unroll") for (int m = 0; m < 4; ++m) _Pragma("unroll") for (int k = 0; k < 2; ++k) dst[m][k] = *(const PG8_LAS bf16x8*)(lds + PG8_SA(b, h) + aoff + m * 2048 + k * 1024); } while (0)
#define PG8_LDB(dst, b, h) do { _Pragma("unroll") for (int n = 0; n < 2; ++n) _Pragma("unroll") for (int k = 0; k < 2; ++k) dst[n][k] = *(const PG8_LAS bf16x8*)(lds + PG8_SB(b, h) + boff + n * 2048 + k * 1024); } while (0)
#define PG8_MMA(ai, bj, At, Bt) do { __builtin_amdgcn_s_setprio(1); _Pragma("unroll") for (int m = 0; m < 4; ++m) _Pragma("unroll") for (int n = 0; n < 2; ++n) _Pragma("unroll") for (int k = 0; k < 2; ++k) \
        acc[ai][bj][m][n] = __builtin_amdgcn_mfma_f32_16x16x32_bf16(Bt[n][k], At[m][k], acc[ai][bj][m][n], 0, 0, 0); __builtin_amdgcn_s_setprio(0); } while (0)
#define PG8_WAIT_V(n) asm volatile("s_waitcnt vmcnt(" #n ")" ::: "memory")
#define PG8_WAIT_L(n) asm volatile("s_waitcnt lgkmcnt(" #n ")" ::: "memory")
#define PG8_BAR __builtin_amdgcn_s_barrier()
#define PG8_SCHED __builtin_amdgcn_sched_barrier(0)
    Unit cur, nxt; int ui = 0; typename MidT<Epi, Epi::MID>::type ms;
    if (!S.next(0, cur)) return;
    f32x4 acc[2][2][4][2];
#pragma unroll
    for (int a = 0; a < 2; ++a)
#pragma unroll
        for (int b = 0; b < 2; ++b)
#pragma unroll
            for (int m = 0; m < 4; ++m)
#pragma unroll
                for (int n = 0; n < 2; ++n) acc[a][b][m][n] = (f32x4){0.f, 0.f, 0.f, 0.f};
    bf16x8 At[4][2], B0[2][2], B1[2][2];
    const char* cA = (const char*)g.A + (size_t)cur.pm * tstep; const char* cB = (const char*)g.Bt + (size_t)cur.pn * tstep;
    S.a_ready(cur);
    if constexpr (SP2) {
        PG8_STAGE(PG8_SB(0, 0), cB, voffB); PG8_STAGE(PG8_SB(0, 1), cB + hstep, voffB); PG8_STAGE(PG8_SA(0, 0), cA, voffA); PG8_STAGE(PG8_SA(0, 1), cA + hstep, voffA);
        if (wr == 1) PG8_BAR;
        PG8_WAIT_V(2); PG8_BAR;
        PG8_STAGE(PG8_SB(1, 0), cB + kstep, voffB); PG8_STAGE(PG8_SA(1, 0), cA + kstep, voffA); PG8_STAGE(PG8_SB(1, 1), cB + hstep + kstep, voffB);
        PG8_WAIT_V(6); PG8_BAR;
    } else {
        PG8_STAGE(PG8_SB(0, 0), cB, voffB); PG8_STAGE(PG8_SA(0, 0), cA, voffA); PG8_STAGE(PG8_SB(0, 1), cB + hstep, voffB); PG8_STAGE(PG8_SA(0, 1), cA + hstep, voffA);
        if (wr == 1) PG8_BAR;
        PG8_WAIT_V(4); PG8_BAR;
        PG8_STAGE(PG8_SB(1, 0), cB + kstep, voffB); PG8_STAGE(PG8_SA(1, 0), cA + kstep, voffA); PG8_STAGE(PG8_SB(1, 1), cB + hstep + kstep, voffB);
        PG8_WAIT_V(6); PG8_BAR;
    }
    for (;;) {
        const bool has_next = S.next(ui + 1, nxt);
        const char* nA = has_next ? (const char*)g.A + (size_t)nxt.pm * tstep : cA; const char* nB = has_next ? (const char*)g.Bt + (size_t)nxt.pn * tstep : cB;
        for (int t = 0; t < nt; t += 2) {
            if constexpr (Epi::MID) { if (t == (nt >> 1)) E.mid(acc, ms, cur, wr, wc, fr, fq); }
            const bool last = (t == nt - 2);
            const char* a1 = cA + (size_t)(t + 1) * kstep;
            const char* a2 = last ? nA : cA + (size_t)(t + 2) * kstep; const char* b2 = last ? nB : cB + (size_t)(t + 2) * kstep;
            const char* a3 = a2 + kstep; const char* b3 = b2 + kstep;
            if (last && has_next) S.a_ready(nxt);
            if constexpr (SP2) {
            PG8_LDB(B0, 0, 0); PG8_LDB(B1, 0, 1); PG8_SCHED; PG8_LDA(At, 0, 0); PG8_STAGE(PG8_SA(1, 1), a1 + hstep, voffA);
            PG8_WAIT_V(8); PG8_WAIT_L(0); PG8_BAR; PG8_MMA(0, 0, At, B0); PG8_MMA(0, 1, At, B1); PG8_BAR; PG8_SCHED;
            PG8_LDA(At, 0, 1); PG8_STAGE(PG8_SB(0, 0), b2, voffB); PG8_STAGE(PG8_SB(0, 1), b2 + hstep, voffB); PG8_STAGE(PG8_SA(0, 0), a2, voffA);
            PG8_WAIT_V(8); PG8_WAIT_L(0); PG8_BAR; PG8_MMA(1, 0, At, B0); PG8_MMA(1, 1, At, B1); PG8_BAR; PG8_SCHED;
            PG8_LDB(B0, 1, 0); PG8_LDB(B1, 1, 1); PG8_SCHED; PG8_LDA(At, 1, 0); PG8_STAGE(PG8_SA(0, 1), a2 + hstep, voffA);
            PG8_WAIT_V(8); PG8_WAIT_L(0); PG8_BAR; PG8_MMA(0, 0, At, B0); PG8_MMA(0, 1, At, B1); PG8_BAR; PG8_SCHED;
            PG8_LDA(At, 1, 1); PG8_STAGE(PG8_SB(1, 0), b3, voffB); PG8_STAGE(PG8_SB(1, 1), b3 + hstep, voffB); PG8_STAGE(PG8_SA(1, 0), a3, voffA);
            PG8_WAIT_V(8); PG8_WAIT_L(0); PG8_BAR; PG8_MMA(1, 0, At, B0); PG8_MMA(1, 1, At, B1); PG8_BAR; PG8_SCHED;
            } else {
            PG8_LDB(B0, 0, 0); PG8_SCHED; PG8_LDA(At, 0, 0); PG8_STAGE(PG8_SA(1, 1), a1 + hstep, voffA);
            PG8_WAIT_L(8); PG8_BAR; PG8_WAIT_L(0); PG8_MMA(0, 0, At, B0); PG8_BAR; PG8_SCHED;
            PG8_LDB(B1, 0, 1); PG8_STAGE(PG8_SB(0, 0), b2, voffB);
            PG8_BAR; PG8_WAIT_L(0); PG8_MMA(0, 1, At, B1); PG8_BAR;
            PG8_LDA(At, 0, 1); PG8_STAGE(PG8_SA(0, 0), a2, voffA);
            PG8_BAR; PG8_WAIT_L(0); PG8_MMA(1, 0, At, B0); PG8_BAR; PG8_SCHED;
            PG8_STAGE(PG8_SB(0, 1), b2 + hstep, voffB);
            PG8_WAIT_V(6); PG8_BAR; PG8_MMA(1, 1, At, B1); PG8_BAR;
            PG8_LDB(B0, 1, 0); PG8_SCHED; PG8_LDA(At, 1, 0); PG8_STAGE(PG8_SA(0, 1), a2 + hstep, voffA);
            PG8_WAIT_L(8); PG8_BAR; PG8_WAIT_L(0); PG8_MMA(0, 0, At, B0); PG8_BAR; PG8_SCHED;
            PG8_LDB(B1, 1, 1); PG8_STAGE(PG8_SB(1, 0), b3, voffB);
            PG8_BAR; PG8_WAIT_L(0); PG8_MMA(0, 1, At, B1); PG8_BAR;
            PG8_LDA(At, 1, 1); PG8_STAGE(PG8_SA(1, 0), a3, voffA);
            PG8_BAR; PG8_WAIT_L(0); PG8_MMA(1, 0, At, B0); PG8_BAR; PG8_SCHED;
            PG8_STAGE(PG8_SB(1, 1), b3 + hstep, voffB);
            PG8_WAIT_V(6); PG8_BAR; PG8_MMA(1, 1, At, B1); PG8_BAR;
            }
        }
        if constexpr (ALIGN_EPI) { if (wr == 0) PG8_BAR; }
        if constexpr (!Epi::AFTER_DRAIN) { if constexpr (Epi::MID) E(acc, ms, cur, wr, wc, fr, fq); else E(acc, cur, wr, wc, fr, fq); S.done(cur); }
        if (!has_next) break;
#pragma unroll
        for (int a = 0; a < 2; ++a)
#pragma unroll
            for (int b = 0; b < 2; ++b)
#pragma unroll
                for (int m = 0; m < 4; ++m)
#pragma unroll
                    for (int n = 0; n < 2; ++n) acc[a][b][m][n] = (f32x4){0.f, 0.f, 0.f, 0.f};
        cur = nxt; cA = nA; cB = nB; ++ui;
        if constexpr (ALIGN_EPI) { if (wr == 1) PG8_BAR; }
    }
    PG8_WAIT_V(0);
    if constexpr (!ALIGN_EPI) { if (wr == 0) PG8_BAR; }
    PG8_BAR;
    if constexpr (Epi::AFTER_DRAIN) { E.fused(acc, cur, wr, wc, fr, fq, lds, wid, lane); S.done(cur); }
#undef PG8_SA
#undef PG8_SB
#undef PG8_STAGE
#undef PG8_LDA
#undef PG8_LDB
#undef PG8_MMA
#undef PG8_WAIT_V
#undef PG8_WAIT_L
#undef PG8_BAR
#undef PG8_SCHED
}
}
namespace attn {
using bf16 = unsigned short;
constexpr int   D = 128, NW = 8, QBLK = 32, KVBLK = 64;
constexpr float SCALE = 0.088388347648318440f;
constexpr float THR = 8.f;
constexpr int SDEPTH = 1;
constexpr int LDQ = 2048, LDK = 512, LDO = 4096;
#ifndef ATTN_PVPIPE
#define ATTN_PVPIPE 0
#endif
#ifndef ATTN_DMA
#define ATTN_DMA 1
#endif
constexpr int NSTG = ATTN_DMA ? 3 : 2;
constexpr size_t SHM_V = KVBLK * D * 2, SHM_K = KVBLK * D * 2, SHM_ATTN = NSTG * SHM_V + NSTG * SHM_K + NW * 64 * 4;
using bf16x8 = __attribute__((ext_vector_type(8))) short;
using s16x4  = __attribute__((ext_vector_type(4))) short;
using f32x16 = __attribute__((ext_vector_type(16))) float;
using f32x8  = __attribute__((ext_vector_type(8))) float;
using u32x4  = __attribute__((ext_vector_type(4))) unsigned;
#define KSWZ(row, colB) ((row) * 256 + ((colB) ^ (((row) & 7) << 4)))
#define SBAR() __builtin_amdgcn_sched_barrier(0)
__device__ __forceinline__ int crow(int r, int hi) { return (r & 3) + 8 * (r >> 2) + 4 * hi; }
__device__ __forceinline__ unsigned cvtpk(float lo, float hi) {
  unsigned r; asm volatile("v_cvt_pk_bf16_f32 %0, %1, %2" : "=v"(r) : "v"(lo), "v"(hi)); return r;
}
struct StageB { using T = bf16x8;
  __device__ static __forceinline__ T ld8(const bf16* p) { return *reinterpret_cast<const bf16x8*>(p); }
  __device__ static __forceinline__ bf16x8 tobf(T x) { return x; } };
__device__ __forceinline__ void partialSM(f32x16& p0, f32x16& p1, float& m_reg, float& mn, float& alpha) {
  constexpr float C = SCALE * 1.4426950408889634f;
  float pmax = p0[0]; for (int r = 1; r < 16; ++r) pmax = fmaxf(pmax, p0[r]); for (int r = 0; r < 16; ++r) pmax = fmaxf(pmax, p1[r]);
  { auto rr = __builtin_amdgcn_permlane32_swap(__float_as_uint(pmax), __float_as_uint(pmax), false, false);
    pmax = fmaxf(__uint_as_float(rr[0]), __uint_as_float(rr[1])); }
  if (__builtin_expect(__all(pmax - m_reg <= THR / SCALE), 1)) { mn = m_reg; alpha = 1.f; }
  else { mn = fmaxf(m_reg, pmax); alpha = __builtin_amdgcn_exp2f((m_reg - mn) * C); m_reg = mn; }
  float mnC = -mn * C;
  for (int r = 0; r < 16; ++r) p0[r] = fmaf(p0[r], C, mnC); for (int r = 0; r < 16; ++r) p1[r] = fmaf(p1[r], C, mnC);
  for (int r = 0; r < 16; ++r) p0[r] = __builtin_amdgcn_exp2f(p0[r]);
}
__device__ __forceinline__ void finishSM(f32x16& p0, f32x16& p1, float alpha, float& l_reg, bf16x8& pa0, bf16x8& pa1, bf16x8& pa2, bf16x8& pa3) {
  for (int r = 0; r < 16; ++r) p1[r] = __builtin_amdgcn_exp2f(p1[r]);
  float ps = 0; for (int r = 0; r < 16; ++r) ps += p0[r]; for (int r = 0; r < 16; ++r) ps += p1[r];
  { auto rr = __builtin_amdgcn_permlane32_swap(__float_as_uint(ps), __float_as_uint(ps), false, false);
    ps = __uint_as_float(rr[0]) + __uint_as_float(rr[1]); }
  l_reg = l_reg * alpha + ps;
#define PK4(P, BASE, OUT) do { unsigned a0 = cvtpk(P[BASE + 0], P[BASE + 1]), a1 = cvtpk(P[BASE + 2], P[BASE + 3]);   \
    unsigned b0 = cvtpk(P[BASE + 4], P[BASE + 5]), b1 = cvtpk(P[BASE + 6], P[BASE + 7]);                              \
    auto r0 = __builtin_amdgcn_permlane32_swap(a0, b0, false, false); auto r1 = __builtin_amdgcn_permlane32_swap(a1, b1, false, false); \
    u32x4 w = {r0[0], r1[0], r0[1], r1[1]}; OUT = *reinterpret_cast<bf16x8*>(&w); } while (0)
  PK4(p0, 0, pa0); PK4(p0, 8, pa1); PK4(p1, 0, pa2); PK4(p1, 8, pa3);
#undef PK4
}
__device__ __forceinline__ void qkt(f32x16& p0, f32x16& p1, const bf16* Ks, const bf16x8* qr, int r32, int hi) {
  p0 = f32x16{}; p1 = f32x16{};
  for (int d0 = 0; d0 < 8; ++d0) { int cb = (d0 * 16 + hi * 8) * 2;
    bf16x8 b0 = *reinterpret_cast<const bf16x8*>((const char*)Ks + KSWZ(r32, cb));
    bf16x8 b1 = *reinterpret_cast<const bf16x8*>((const char*)Ks + KSWZ(32 + r32, cb));
    p0 = __builtin_amdgcn_mfma_f32_32x32x16_bf16(b0, qr[d0], p0, 0, 0, 0);
    p1 = __builtin_amdgcn_mfma_f32_32x32x16_bf16(b1, qr[d0], p1, 0, 0, 0); }
}
__device__ __forceinline__ int v_st(int k, int c) { const int kk = (k & ~0xC) | ((k & 4) << 1) | ((k & 8) >> 1); return ((kk >> 3) * 4 + (c >> 5)) * 512 + ((kk & 7) * 32 + (c & 31)) * 2; }
__device__ __forceinline__ int v_rd_base(int lane) { return ((lane & 3) << 3) | (((lane >> 2) & 3) << 6) | (((lane >> 4) & 1) << 5) | (((lane >> 5) & 1) << 8); }
constexpr int v_rd_off(int d0, int ks, int half) { return d0 * 512 + ks * 4096 + half * 2048; }
template <int OFF> __device__ __forceinline__ s16x4 tr_read(int vb) {
  s16x4 r; asm volatile("ds_read_b64_tr_b16 %0, %1 offset:%2" : "=&v"(r) : "v"(vb), "i"(OFF) : "memory"); return r;
}
template <int D0> __device__ __forceinline__ void pv_one(f32x16& od, int vb, bf16x8 pa0, bf16x8 pa1, bf16x8 pa2, bf16x8 pa3) {
  const s16x4 l0 = tr_read<v_rd_off(D0, 0, 0)>(vb), h0 = tr_read<v_rd_off(D0, 0, 1)>(vb), l1 = tr_read<v_rd_off(D0, 1, 0)>(vb), h1 = tr_read<v_rd_off(D0, 1, 1)>(vb);
  const s16x4 l2 = tr_read<v_rd_off(D0, 2, 0)>(vb), h2 = tr_read<v_rd_off(D0, 2, 1)>(vb), l3 = tr_read<v_rd_off(D0, 3, 0)>(vb), h3 = tr_read<v_rd_off(D0, 3, 1)>(vb);
  asm volatile("s_waitcnt lgkmcnt(0)" ::: "memory"); SBAR();
#define PK(L, H) (bf16x8){L[0], L[1], L[2], L[3], H[0], H[1], H[2], H[3]}
  od = __builtin_amdgcn_mfma_f32_32x32x16_bf16(pa0, PK(l0, h0), od, 0, 0, 0);
  od = __builtin_amdgcn_mfma_f32_32x32x16_bf16(pa1, PK(l1, h1), od, 0, 0, 0);
  od = __builtin_amdgcn_mfma_f32_32x32x16_bf16(pa2, PK(l2, h2), od, 0, 0, 0);
  od = __builtin_amdgcn_mfma_f32_32x32x16_bf16(pa3, PK(l3, h3), od, 0, 0, 0);
#undef PK
}
#if ATTN_PVPIPE
template <int D0> __device__ __forceinline__ void pv_rd(int vb, s16x4 (&f)[8]) {
  f[0] = tr_read<v_rd_off(D0, 0, 0)>(vb); f[1] = tr_read<v_rd_off(D0, 0, 1)>(vb); f[2] = tr_read<v_rd_off(D0, 1, 0)>(vb); f[3] = tr_read<v_rd_off(D0, 1, 1)>(vb);
  f[4] = tr_read<v_rd_off(D0, 2, 0)>(vb); f[5] = tr_read<v_rd_off(D0, 2, 1)>(vb); f[6] = tr_read<v_rd_off(D0, 3, 0)>(vb); f[7] = tr_read<v_rd_off(D0, 3, 1)>(vb);
}
__device__ __forceinline__ void pv_mm(f32x16& od, const s16x4 (&f)[8], bf16x8 pa0, bf16x8 pa1, bf16x8 pa2, bf16x8 pa3) {
#define PK(L, H) (bf16x8){L[0], L[1], L[2], L[3], H[0], H[1], H[2], H[3]}
  od = __builtin_amdgcn_mfma_f32_32x32x16_bf16(pa0, PK(f[0], f[1]), od, 0, 0, 0);
  od = __builtin_amdgcn_mfma_f32_32x32x16_bf16(pa1, PK(f[2], f[3]), od, 0, 0, 0);
  od = __builtin_amdgcn_mfma_f32_32x32x16_bf16(pa2, PK(f[4], f[5]), od, 0, 0, 0);
  od = __builtin_amdgcn_mfma_f32_32x32x16_bf16(pa3, PK(f[6], f[7]), od, 0, 0, 0);
#undef PK
}
template <int D0> __device__ __forceinline__ void pv_lo(int vb, s16x4 (&f)[4]) {
  f[0] = tr_read<v_rd_off(D0, 0, 0)>(vb); f[1] = tr_read<v_rd_off(D0, 0, 1)>(vb); f[2] = tr_read<v_rd_off(D0, 1, 0)>(vb); f[3] = tr_read<v_rd_off(D0, 1, 1)>(vb); }
template <int D0> __device__ __forceinline__ void pv_hi(int vb, s16x4 (&f)[4]) {
  f[0] = tr_read<v_rd_off(D0, 2, 0)>(vb); f[1] = tr_read<v_rd_off(D0, 2, 1)>(vb); f[2] = tr_read<v_rd_off(D0, 3, 0)>(vb); f[3] = tr_read<v_rd_off(D0, 3, 1)>(vb); }
#define PK(L, H) (bf16x8){L[0], L[1], L[2], L[3], H[0], H[1], H[2], H[3]}
#define PV_LO(od, f) do { od = __builtin_amdgcn_mfma_f32_32x32x16_bf16(pa0, PK(f[0], f[1]), od, 0, 0, 0); od = __builtin_amdgcn_mfma_f32_32x32x16_bf16(pa1, PK(f[2], f[3]), od, 0, 0, 0); } while (0)
#define PV_HI(od, f) do { od = __builtin_amdgcn_mfma_f32_32x32x16_bf16(pa2, PK(f[0], f[1]), od, 0, 0, 0); od = __builtin_amdgcn_mfma_f32_32x32x16_bf16(pa3, PK(f[2], f[3]), od, 0, 0, 0); } while (0)
#define LGKM(n) asm volatile("s_waitcnt lgkmcnt(" #n ")" ::: "memory")
__device__ __forceinline__ void pv_d0(f32x16* o, int vb, bf16x8 pa0, bf16x8 pa1, bf16x8 pa2, bf16x8 pa3) {
  s16x4 fa[4], fb[4], fc[4];
  pv_lo<0>(vb, fa); pv_hi<0>(vb, fb);
  pv_lo<1>(vb, fc); LGKM(8); SBAR(); PV_LO(o[0], fa); SBAR();
  pv_hi<1>(vb, fa); LGKM(8); SBAR(); PV_HI(o[0], fb); SBAR();
  pv_lo<2>(vb, fb); LGKM(8); SBAR(); PV_LO(o[1], fc); SBAR();
  pv_hi<2>(vb, fc); LGKM(8); SBAR(); PV_HI(o[1], fa); SBAR();
  pv_lo<3>(vb, fa); LGKM(8); SBAR(); PV_LO(o[2], fb); SBAR();
  pv_hi<3>(vb, fb); LGKM(8); SBAR(); PV_HI(o[2], fc); SBAR();
  LGKM(4); SBAR(); PV_LO(o[3], fa); SBAR();
  LGKM(0); SBAR(); PV_HI(o[3], fb);
}
#undef PK
#undef PV_LO
#undef PV_HI
#undef LGKM
#else
__device__ __forceinline__ void pv_d0(f32x16* o, int vb, bf16x8 pa0, bf16x8 pa1, bf16x8 pa2, bf16x8 pa3) {
  pv_one<0>(o[0], vb, pa0, pa1, pa2, pa3); pv_one<1>(o[1], vb, pa0, pa1, pa2, pa3); pv_one<2>(o[2], vb, pa0, pa1, pa2, pa3); pv_one<3>(o[3], vb, pa0, pa1, pa2, pa3);
}
#endif

__device__ __forceinline__ void attn_dense_body(const bf16* Qb, const bf16* __restrict__ Kh, const bf16* __restrict__ Vh,
                                                bf16* Obase, int orow0, int ocol0, int seq, char* lds, const float* qgain, int pos0) {
  using St = StageB; using SQ = StageB;
  int tid_ = threadIdx.x; asm volatile("" : "+v"(tid_));
  const int tid = tid_, wid = __builtin_amdgcn_readfirstlane(tid >> 6), lane = tid & 63, r32 = lane & 31, hi = lane >> 5;
  bf16* V_lds = (bf16*)lds; bf16* K_lds = (bf16*)(lds + NSTG * SHM_V);
  float* ws = (float*)(lds + NSTG * SHM_V + NSTG * SHM_K) + wid * 64; float* li_l = ws; float* al_l = ws + 32;
  float m_reg = -1e30f, l_reg = 0; f32x16 o[4] = {}; bf16x8 qr[8];
  const bf16* Qw = Qb + (long)(wid * QBLK + r32) * LDQ + hi * 8;
#pragma unroll
  for (int d0 = 0; d0 < 8; ++d0) qr[d0] = SQ::tobf(SQ::ld8(Qw + d0 * 16));
#if !ATTN_DMA
#ifndef ATTN_NO_QROPE
  {
    float ssq = 0.f;
#pragma unroll
    for (int d0 = 0; d0 < 8; ++d0)
#pragma unroll
      for (int e = 0; e < 8; ++e) { const float x = __uint_as_float((unsigned)(unsigned short)qr[d0][e] << 16); ssq = fmaf(x, x, ssq); }
    ssq += __shfl_xor(ssq, 32);
    const float rs = 1.0f / sqrtf(ssq * (1.0f / 128.0f) + 1e-6f);
    const int pos = pos0 + wid * QBLK + r32; const float prow = (float)(pos >> 6), pcol = (float)(pos & 63);
    float inv[4][4];
#pragma unroll
    for (int a = 0; a < 4; ++a)
#pragma unroll
      for (int j = 0; j < 4; ++j) inv[a][j] = __builtin_amdgcn_exp2f(-(float)(8 * a + 4 * hi + j) * (13.287712379549449f / 32.0f));
#pragma unroll
    for (int d0 = 0; d0 < 8; ++d0) { const float pf = d0 < 4 ? prow : pcol; const float* gp = qgain + 16 * d0 + 8 * hi;
      unsigned w[4];
#pragma unroll
      for (int j = 0; j < 4; ++j) { const float ang = pf * inv[d0 & 3][j]; const float cs = __cosf(ang), sn = __sinf(ang);
        const float x0 = __uint_as_float((unsigned)(unsigned short)qr[d0][2 * j] << 16), x1 = __uint_as_float((unsigned)(unsigned short)qr[d0][2 * j + 1] << 16);
        const float a = x0 * rs * gp[2 * j], b = x1 * rs * gp[2 * j + 1];
        w[j] = cvtpk(a * cs - b * sn, a * sn + b * cs); }
      u32x4 wv = {w[0], w[1], w[2], w[3]}; qr[d0] = *reinterpret_cast<bf16x8*>(&wv); }
  }
#endif
#endif
#if ATTN_DMA
  int koff[2], voff[2];
#pragma unroll
  for (int i = 0; i < 2; ++i) { const int q = i * 512 + wid * 64 + lane, row = q >> 4;
    koff[i] = row * LDK + 8 * ((q & 15) ^ (row & 7));
    const int kk = ((q >> 7) << 3) | ((q >> 2) & 7), k = (kk & ~0xC) | ((kk & 4) << 1) | ((kk & 8) >> 1), cc = (((q >> 5) & 3) << 2) | (q & 3);
    voff[i] = k * LDK + 8 * cc; }
  const unsigned ldsV = (unsigned)(uintptr_t)V_lds + (unsigned)wid * 1024u, ldsK = (unsigned)(uintptr_t)K_lds + (unsigned)wid * 1024u;
  const int vb0 = (int)(uintptr_t)V_lds + v_rd_base(lane);
#define ADMA(t) do { const int st_ = ((t) % 3) * (int)SHM_V; const long g_ = (long)(t) * KVBLK * LDK; _Pragma("unroll") for (int i_ = 0; i_ < 2; ++i_) { \
    __builtin_amdgcn_global_load_lds((const unsigned*)(Kh + g_ + koff[i_]), (__attribute__((address_space(3))) unsigned*)(ldsK + st_ + i_ * 8192), 16, 0, 0); \
    __builtin_amdgcn_global_load_lds((const unsigned*)(Vh + g_ + voff[i_]), (__attribute__((address_space(3))) unsigned*)(ldsV + st_ + i_ * 8192), 16, 0, 0); } } while (0)
#define KST(t) ((bf16*)((char*)K_lds + ((t) % 3) * SHM_K))
#define VST(t) (vb0 + ((t) % 3) * (int)SHM_V)
#define RESC(a) do { if (__any((a) < 1.f)) { if (hi == 0) al_l[r32] = (a); asm volatile("s_waitcnt lgkmcnt(0)" ::: "memory"); \
    for (int d = 0; d < 4; ++d) for (int r = 0; r < 16; ++r) o[d][r] *= al_l[crow(r, hi)]; } } while (0)
#define LAND() do { asm volatile("s_waitcnt vmcnt(0)" ::: "memory"); __syncthreads(); } while (0)
  f32x16 pA0, pA1, pB0, pB1; float mnA, mnB, alA, alB; bf16x8 pa0, pa1, pa2, pa3; const int NT = seq / KVBLK;
  ADMA(0); ADMA(1); SBAR();
#ifndef ATTN_NO_QROPE
  {
    float ssq = 0.f;
#pragma unroll
    for (int d0 = 0; d0 < 8; ++d0)
#pragma unroll
      for (int e = 0; e < 8; ++e) { const float x = __uint_as_float((unsigned)(unsigned short)qr[d0][e] << 16); ssq = fmaf(x, x, ssq); }
    ssq += __shfl_xor(ssq, 32);
    const float rs = 1.0f / sqrtf(ssq * (1.0f / 128.0f) + 1e-6f);
    const int pos = pos0 + wid * QBLK + r32; const float prow = (float)(pos >> 6), pcol = (float)(pos & 63);
    float inv[4][4];
#pragma unroll
    for (int a = 0; a < 4; ++a)
#pragma unroll
      for (int j = 0; j < 4; ++j) inv[a][j] = __builtin_amdgcn_exp2f(-(float)(8 * a + 4 * hi + j) * (13.287712379549449f / 32.0f));
#pragma unroll
    for (int d0 = 0; d0 < 8; ++d0) { const float pf = d0 < 4 ? prow : pcol; const float* gp = qgain + 16 * d0 + 8 * hi;
      unsigned w[4];
#pragma unroll
      for (int j = 0; j < 4; ++j) { const float ang = pf * inv[d0 & 3][j]; const float cs = __cosf(ang), sn = __sinf(ang);
        const float x0 = __uint_as_float((unsigned)(unsigned short)qr[d0][2 * j] << 16), x1 = __uint_as_float((unsigned)(unsigned short)qr[d0][2 * j + 1] << 16);
        const float a = x0 * rs * gp[2 * j], b = x1 * rs * gp[2 * j + 1];
        w[j] = cvtpk(a * cs - b * sn, a * sn + b * cs); }
      u32x4 wv = {w[0], w[1], w[2], w[3]}; qr[d0] = *reinterpret_cast<bf16x8*>(&wv); }
  }
#endif
  asm volatile("s_waitcnt vmcnt(4)" ::: "memory"); __syncthreads();
  qkt(pA0, pA1, KST(0), qr, r32, hi); partialSM(pA0, pA1, m_reg, mnA, alA);
  LAND(); ADMA(2);
  for (int j = 1; j + 1 < NT; j += 2) {
    SBAR(); qkt(pB0, pB1, KST(j), qr, r32, hi);
    finishSM(pA0, pA1, alA, l_reg, pa0, pa1, pa2, pa3); SBAR();
    pv_d0(o, VST(j - 1), pa0, pa1, pa2, pa3); partialSM(pB0, pB1, m_reg, mnB, alB);
    LAND(); ADMA(j + 2);
    RESC(alB);
    SBAR(); qkt(pA0, pA1, KST(j + 1), qr, r32, hi);
    finishSM(pB0, pB1, alB, l_reg, pa0, pa1, pa2, pa3); SBAR();
    pv_d0(o, VST(j), pa0, pa1, pa2, pa3); partialSM(pA0, pA1, m_reg, mnA, alA);
    LAND(); if (j + 3 < NT) ADMA(j + 3);
    RESC(alA);
  }
  SBAR(); qkt(pB0, pB1, KST(NT - 1), qr, r32, hi);
  finishSM(pA0, pA1, alA, l_reg, pa0, pa1, pa2, pa3); SBAR();
  pv_d0(o, VST(NT - 2), pa0, pa1, pa2, pa3); partialSM(pB0, pB1, m_reg, mnB, alB);
  RESC(alB);
  finishSM(pB0, pB1, alB, l_reg, pa0, pa1, pa2, pa3); SBAR();
  pv_d0(o, VST(NT - 1), pa0, pa1, pa2, pa3);
#undef ADMA
#undef KST
#undef VST
#undef LAND
#else
  const int sr = tid >> 4, sc = (tid & 15) * 8, vst0 = v_st(sr, sc), vst1 = v_st(32 + sr, sc);
  const int vb0 = (int)(uintptr_t)V_lds + v_rd_base(lane);
  struct { typename St::T vs0, vs1, ks0, ks1; } sr_[SDEPTH];
#define SLOAD(i, k0) do { sr_[i].vs0 = St::ld8(&Vh[(long)((k0) + sr) * LDK + sc]); sr_[i].vs1 = St::ld8(&Vh[(long)((k0) + 32 + sr) * LDK + sc]); \
    sr_[i].ks0 = St::ld8(&Kh[(long)((k0) + sr) * LDK + sc]); sr_[i].ks1 = St::ld8(&Kh[(long)((k0) + 32 + sr) * LDK + sc]); } while (0)
#define SWRITE(b, i) do { *(bf16x8*)((char*)V_lds + (b) * SHM_V + vst0) = St::tobf(sr_[i].vs0);          \
    *(bf16x8*)((char*)V_lds + (b) * SHM_V + vst1) = St::tobf(sr_[i].vs1); int kc = sc * 2;               \
    *(bf16x8*)((char*)K_lds + (b) * SHM_K + KSWZ(sr, kc)) = St::tobf(sr_[i].ks0);                       \
    *(bf16x8*)((char*)K_lds + (b) * SHM_K + KSWZ(32 + sr, kc)) = St::tobf(sr_[i].ks1); } while (0)
#define SWAIT() do { if constexpr (SDEPTH == 2) asm volatile("s_waitcnt vmcnt(4)" ::: "memory"); else asm volatile("s_waitcnt vmcnt(0)" ::: "memory"); } while (0)
#define RESC(a) do { if (__any((a) < 1.f)) { if (hi == 0) al_l[r32] = (a); asm volatile("s_waitcnt lgkmcnt(0)" ::: "memory"); \
    for (int d = 0; d < 4; ++d) for (int r = 0; r < 16; ++r) o[d][r] *= al_l[crow(r, hi)]; } } while (0)
  f32x16 pA0, pA1, pB0, pB1; float mnA, mnB, alA, alB; bf16x8 pa0, pa1, pa2, pa3; const int NT = seq / KVBLK;
  constexpr int SE = 0, SO = SDEPTH - 1;
  SLOAD(SE, 0); asm volatile("s_waitcnt vmcnt(0)" ::: "memory"); SWRITE(0, SE); __syncthreads();
  qkt(pA0, pA1, K_lds, qr, r32, hi); partialSM(pA0, pA1, m_reg, mnA, alA);
  SLOAD(SO, KVBLK); if constexpr (SDEPTH == 2) { if (2 < NT) SLOAD(SE, 2 * KVBLK); }
  SWAIT(); SWRITE(1, SO); __syncthreads();
  for (int j = 1; j + 1 < NT; j += 2) {
    SBAR(); qkt(pB0, pB1, (bf16*)((char*)K_lds + SHM_K), qr, r32, hi);
    finishSM(pA0, pA1, alA, l_reg, pa0, pa1, pa2, pa3); SBAR();
    SLOAD(SO, (j + SDEPTH) * KVBLK); SBAR();
    pv_d0(o, vb0, pa0, pa1, pa2, pa3); partialSM(pB0, pB1, m_reg, mnB, alB);
    __syncthreads(); SWAIT(); SWRITE(0, SE);
    RESC(alB); __syncthreads();
    SBAR(); qkt(pA0, pA1, K_lds, qr, r32, hi);
    finishSM(pB0, pB1, alB, l_reg, pa0, pa1, pa2, pa3); SBAR();
    if (SDEPTH == 1 || j + 3 < NT) SLOAD(SE, (j + 1 + SDEPTH) * KVBLK); SBAR();
    pv_d0(o, vb0 + (int)SHM_V, pa0, pa1, pa2, pa3); partialSM(pA0, pA1, m_reg, mnA, alA);
    __syncthreads(); SWAIT(); SWRITE(1, SO);
    RESC(alA); __syncthreads();
  }
  SBAR(); qkt(pB0, pB1, (bf16*)((char*)K_lds + SHM_K), qr, r32, hi);
  finishSM(pA0, pA1, alA, l_reg, pa0, pa1, pa2, pa3); SBAR();
  pv_d0(o, vb0, pa0, pa1, pa2, pa3); partialSM(pB0, pB1, m_reg, mnB, alB);
  __syncthreads(); RESC(alB);
  finishSM(pB0, pB1, alB, l_reg, pa0, pa1, pa2, pa3); SBAR();
  pv_d0(o, vb0 + (int)SHM_V, pa0, pa1, pa2, pa3);
#endif
  if (hi == 0) li_l[r32] = l_reg; asm volatile("s_waitcnt lgkmcnt(0)" ::: "memory");
  float rli[16];
#pragma unroll
  for (int r = 0; r < 16; ++r) rli[r] = __builtin_amdgcn_rcpf(li_l[crow(r, hi)]);
  __syncthreads();
  char* ost = lds + wid * 8192;
#pragma unroll
  for (int r = 0; r < 16; ++r) { const int orow = crow(r, hi);
#pragma unroll
    for (int d0 = 0; d0 < 4; ++d0) { const float v = o[d0][r] * rli[r]; unsigned u = __float_as_uint(v); u = (u + 0x7fffu + ((u >> 16) & 1u)) >> 16;
      *(unsigned short*)(ost + orow * 256 + (d0 * 32 + r32) * 2) = (unsigned short)u; } }
  asm volatile("s_waitcnt lgkmcnt(0)" ::: "memory");
#pragma unroll
  for (int i = 0; i < 8; ++i) { const int row = (lane >> 4) + 4 * i, ch = lane & 15;
    const u32x4 v = *(const u32x4*)(ost + row * 256 + ch * 16); *(u32x4*)(Obase + pg8::toff(orow0 + wid * QBLK + row, ocol0 + ch * 8, LDO)) = v; }
  __syncthreads();
#undef SLOAD
#undef SWRITE
#undef SWAIT
#undef RESC
}
}
constexpr int NWAVES = 8;
#ifndef MK_PER_PHASE
#define MK_PER_PHASE 0
#endif
#ifndef MK_STAGE
#define MK_STAGE 9
#endif

constexpr int D = 4096, NTOK_P = 4 * 4096, NTOK_S = 8192, NTOK = NTOK_P + NTOK_S;
constexpr int SEQ_P = 4096, SEQ_S = 8192;
constexpr int HD = 128, NQH = 16, NKVH = 4, AW = NQH * HD  , KVW = NKVH * HD  ;
constexpr int DR = 2048, LRU_NB = 16, LRU_BW = 128;
constexpr int FF = 4 * D, INW = AW + 2 * KVW + 2 * DR + 2 * D;
constexpr float NORM_EPS = 1e-6f;
#ifndef MLP_NCH
#define MLP_NCH 3
#endif
constexpr int MLP_CHUNKS = MLP_NCH, MLP_ROWS = NTOK / MLP_CHUNKS;
constexpr int LCH = 128, NCHUNK = NTOK / LCH;

constexpr size_t MiB = 1u << 20;
constexpr size_t WS_CTL = 0, CTL_ZERO_BYTES = 1 * MiB;
constexpr size_t WS_AGG = 1 * MiB;
constexpr size_t WS_CARRY = 8 * MiB;
constexpr size_t WS_WIN = 12 * MiB, WS_WCAT = 132 * MiB  , WS_WOUT = 164 * MiB, WS_WUP = 196 * MiB, WS_WDN = 324 * MiB;
constexpr size_t WS_A = 452 * MiB;
constexpr size_t WS_H1 = WS_A, WS_AR = WS_A  , WS_HM = WS_A;
constexpr size_t WS_B = 644 * MiB;
constexpr size_t WS_Q = WS_B, WS_K = WS_B + 96 * MiB, WS_V = WS_B + 120 * MiB, WS_XR = WS_B + 144 * MiB, WS_YR = WS_B + 240 * MiB;
constexpr size_t WS_MRG = WS_B, WS_HID = WS_B;
constexpr size_t WS_WF = 1028 * MiB;
constexpr size_t WS_XBX = 1030 * MiB;
constexpr size_t WS_END = 1222 * MiB;
static_assert(WS_WDN + (size_t)D * FF * 2 <= WS_A && WS_YR + (size_t)NTOK * DR * 2 <= WS_WF && WS_HID + (size_t)MLP_ROWS * FF * 2 <= WS_WF, "d_ws map");
constexpr int CW_TMO = 0, CW_CODE = 1;
constexpr int CW_RSQ1 = 32768, CW_RSQ2 = CW_RSQ1 + NTOK, CW_RS0 = CW_RSQ2 + NTOK  ;
static_assert((CW_RS0 + NTOK) * 4 <= (int)CTL_ZERO_BYTES, "CTL words inside the memset region");
constexpr int CW_BAR = 4096;

constexpr int RING_OFF = 0, RING_BYTES = 131072;
constexpr int LDSCTL_OFF = RING_BYTES, MISC_OFF = LDSCTL_OFF + 320;
constexpr int LDS_BYTES = 147456;
static_assert(MISC_OFF + 128 <= LDS_BYTES && LDSCTL_OFF >= RING_BYTES, "LDS map");
#define GAS __attribute__((address_space(1)))
#define LAS __attribute__((address_space(3)))
typedef unsigned short bf16;
typedef unsigned v4u __attribute__((ext_vector_type(4)));
typedef float f32x4 __attribute__((ext_vector_type(4)));
typedef short bf16x8 __attribute__((ext_vector_type(8)));
typedef GAS unsigned gu32;
typedef GAS unsigned long long gu64;
#define RLX_AGENT __ATOMIC_RELAXED, __HIP_MEMORY_SCOPE_AGENT
#define LDS_WAIT() asm volatile("s_waitcnt lgkmcnt(0)" ::: "memory")
#define VM_WAIT() asm volatile("s_waitcnt vmcnt(0)" ::: "memory")
__device__ __forceinline__ unsigned long long rt() { return __builtin_amdgcn_s_memrealtime(); }
__device__ __forceinline__ unsigned f2bf(float f) { unsigned u = __builtin_bit_cast(unsigned, f); return (u + 0x7fffu + ((u >> 16) & 1u)) >> 16; }
__device__ __forceinline__ unsigned pk2(float lo, float hi) { return f2bf(lo) | (f2bf(hi) << 16); }

#define XB_TMO      128
#define XB_XCNT(j)  (256  + 64 * (j))
#define XB_XSUB(j)  (1280 + 64 * (j))
#define XB_XGEN(j)  (2304 + 64 * (j))
#define XB_TOP      3328
#define XB_TOPGEN   3392
#define XCD_BAR_WORDS 3456
#define XB_SPIN_CAP (1u << 18)

__device__ __forceinline__ unsigned xb_ld(unsigned* p)              { return __hip_atomic_load(p, __ATOMIC_RELAXED, __HIP_MEMORY_SCOPE_AGENT); }
__device__ __forceinline__ unsigned xb_add(unsigned* p, unsigned v) { return __hip_atomic_fetch_add(p, v, __ATOMIC_RELAXED, __HIP_MEMORY_SCOPE_AGENT); }
__device__ __forceinline__ unsigned xb_xcc_id() { return (unsigned)__builtin_amdgcn_s_getreg((3 << 11) | 20) & 0xFu; }
#define XB_SPIN(cond, bar) do { unsigned _sp = 0; while (cond) { __builtin_amdgcn_s_sleep(1); \
    if ((++_sp & 255u) == 0u) { if (xb_ld(&(bar)[XB_TMO])) break; if (_sp > XB_SPIN_CAP) { atomicAdd(&(bar)[XB_TMO], 1u); break; } } } } while (0)

struct XcdBarrier {
    unsigned* bar; unsigned x;
    volatile LAS unsigned* st;
};

__device__ __forceinline__ XcdBarrier xcd_barrier_post(unsigned* bar, volatile LAS unsigned* st) {
    XcdBarrier b; b.bar = bar; b.x = xb_xcc_id(); b.st = st;
    if (threadIdx.x == 0) (void)xb_add(&bar[XB_XCNT(b.x)], 1u);
    return b;
}
__device__ __forceinline__ void xcd_barrier_complete(unsigned* bar, unsigned x, unsigned& nloc, unsigned& nx) {
    const unsigned G = gridDim.x * gridDim.y * gridDim.z;
    unsigned sum, cnt, mine, sp = 0u;
    for (;;) {
        sum = 0u; cnt = 0u; mine = 0u;
#pragma unroll
        for (unsigned j = 0; j < 16; ++j) { const unsigned c = xb_ld(&bar[XB_XCNT(j)]); sum += c; cnt += (c > 0u) ? 1u : 0u; mine = (j == x) ? c : mine; }
        if (sum == G) break;
        __builtin_amdgcn_s_sleep(1);
        if ((++sp & 255u) == 0u) { if (xb_ld(&bar[XB_TMO])) break; if (sp > XB_SPIN_CAP) { atomicAdd(&bar[XB_TMO], 1u); break; } }
    }
    nloc = mine > 0u ? mine : 1u; nx = cnt > 0u ? cnt : 1u;
}

__device__ __forceinline__ void xcd_barrier(const XcdBarrier& b) {
    asm volatile("s_waitcnt vmcnt(0)" ::: "memory");
    __syncthreads();
    if (threadIdx.x == 0) {
        unsigned* bar = b.bar;
        __builtin_amdgcn_s_waitcnt(0);
        unsigned nloc = b.st[0], nx = b.st[1];
        if (nloc == 0u) { xcd_barrier_complete(bar, b.x, nloc, nx); b.st[0] = nloc; b.st[1] = nx; }
        const unsigned old = xb_add(&bar[XB_XSUB(b.x)], 1u);
        const unsigned gen = old / nloc;
        if (old + 1u == (gen + 1u) * nloc) {
            __builtin_amdgcn_fence(__ATOMIC_RELEASE, "agent");
            asm volatile("s_waitcnt vmcnt(0)" ::: "memory");
            const unsigned og = xb_add(&bar[XB_TOP], 1u);
            const unsigned tg = og / nx;
            if (og + 1u == (tg + 1u) * nx) xb_add(&bar[XB_TOPGEN], 1u);
            else XB_SPIN(xb_ld(&bar[XB_TOPGEN]) == tg, bar);
            __builtin_amdgcn_fence(__ATOMIC_ACQUIRE, "agent");
            xb_add(&bar[XB_XGEN(b.x)], 1u);
            asm volatile("s_waitcnt vmcnt(0)" ::: "memory");
        } else {
            XB_SPIN(xb_ld(&bar[XB_XGEN(b.x)]) == gen, bar);
            __builtin_amdgcn_fence(__ATOMIC_ACQUIRE, "agent");
            asm volatile("s_waitcnt vmcnt(0)" ::: "memory");
        }
    }
    __syncthreads();
}

struct Frame {
    LAS unsigned char* lds;
    volatile LAS unsigned* MISC;
    gu32* ctl;
    int tid, lane, wave;
    int vcu, G;
    const float* in[21]; float* out; unsigned char* ws;
};
__device__ __forceinline__ float wave_sum(float v) {
#pragma unroll
    for (int o = 1; o < 64; o <<= 1) v += __shfl_xor(v, o);
    return v;
}
__device__ __forceinline__ const float* xrow_ptr(const Frame& F, int row) { return row < NTOK_P ? F.in[0] + (size_t)row * D : F.in[1] + (size_t)(row - NTOK_P) * D; }

struct TrItem { const float* W; bf16* WT; const float* kgain; int N, ldw, koff, k0, n0; };
__device__ __forceinline__ void tr_load(const TrItem& t, int lane, float (&wv)[32]) {
#pragma unroll
    for (int i = 0; i < 32; ++i) { const int kk = 32 * (lane >> 5) + i; wv[i] = t.W[(size_t)(t.k0 + kk) * t.N + t.n0 + (lane & 31)]; }
}
__device__ __forceinline__ void tr_store(const TrItem& t, int lane, LAS float* scr_, const float (&wv)[32]) {
    LAS unsigned* scr = (LAS unsigned*)scr_; const int half = lane >> 5, n = lane & 31;
#pragma unroll
    for (int j = 0; j < 16; ++j) { float lo = wv[2 * j], hi = wv[2 * j + 1];
        if (t.kgain) { lo *= t.kgain[t.k0 + 32 * half + 2 * j]; hi *= t.kgain[t.k0 + 32 * half + 2 * j + 1]; }
        scr[(16 * half + j) * 33 + n] = pg8::cvt_pk_bf16(lo, hi); }
    LDS_WAIT(); asm volatile("" ::: "memory");
    const int c = lane & 7;
#pragma unroll
    for (int jj = 0; jj < 4; ++jj) { const int nn = (lane >> 3) + 8 * jj; const LAS unsigned* s = scr + (4 * c) * 33 + nn;
        v4u o; o.x = s[0]; o.y = s[33]; o.z = s[66]; o.w = s[99];
        *(GAS v4u*)(t.WT + pg8::toff(t.n0 + nn, t.koff + t.k0 + 8 * c, t.ldw)) = o; }
    LDS_WAIT(); asm volatile("" ::: "memory");
}
__device__ __forceinline__ void row_load(const float* xrow, int lane, f32x4 (&v)[16]) {
    const GAS f32x4* xr = (const GAS f32x4*)xrow + lane;
#pragma unroll
    for (int j = 0; j < 16; ++j) v[j] = xr[64 * j];
}
__device__ __forceinline__ void rms_store_bf16(const f32x4 (&v)[16], const float* gain, bf16* obase, int row, int lane) {
    const GAS f32x4* gr = (const GAS f32x4*)gain + lane; float s = 0.f;
#pragma unroll
    for (int j = 0; j < 16; ++j) s += (v[j].x * v[j].x + v[j].y * v[j].y) + (v[j].z * v[j].z + v[j].w * v[j].w);
    const float rs = 1.0f / sqrtf(wave_sum(s) * (1.f / D) + NORM_EPS);
#pragma unroll
    for (int j = 0; j < 16; ++j) { const f32x4 g = gr[64 * j]; const f32x4 o = v[j] * rs * g;
        *(GAS unsigned long long*)(obase + pg8::toff(row, 4 * (lane + 64 * j), D)) = (unsigned long long)pk2(o.x, o.y) | ((unsigned long long)pk2(o.z, o.w) << 32); }
}
__device__ __forceinline__ void x_store_bf16(const f32x4 (&v)[16], bf16* obase, float* rs0, int row, int lane) {
    float s = 0.f;
#pragma unroll
    for (int j = 0; j < 16; ++j) s += (v[j].x * v[j].x + v[j].y * v[j].y) + (v[j].z * v[j].z + v[j].w * v[j].w);
    const float rs = 1.0f / sqrtf(wave_sum(s) * (1.f / D) + NORM_EPS);
    if (lane == 0) rs0[row] = rs;
#pragma unroll
    for (int j = 0; j < 16; ++j) { const f32x4 o = v[j];
        *(GAS unsigned long long*)(obase + pg8::toff(row, 4 * (lane + 64 * j), D)) = (unsigned long long)pk2(o.x, o.y) | ((unsigned long long)pk2(o.z, o.w) << 32); }
}
__device__ __forceinline__ void scale_store_f32(const f32x4 (&v)[16], const float* gain, float sumsq, float* orow, int lane) {
    const GAS f32x4* gr = (const GAS f32x4*)gain + lane; const float rs = 1.0f / sqrtf(sumsq * (1.f / D) + NORM_EPS);
#pragma unroll
    for (int j = 0; j < 16; ++j) ((GAS f32x4*)orow)[lane + 64 * j] = v[j] * rs * gr[64 * j];
}
constexpr int I_IN = (D / 64) * (INW / 32), I_AT = (AW / 64) * (D / 32), I_RN = (DR / 64) * (D / 32), I_OUT = (D / 64) * (D / 32), I_UP = (D / 64) * (FF / 32), I_DN = (FF / 64) * (D / 32);
constexpr int NITEMS_B = I_AT + I_RN + I_OUT + I_UP + I_DN;
__device__ __forceinline__ TrItem tr_decode(const Frame& F, int r) {
    unsigned char* ws = F.ws; const float* W; bf16* WT; const float* kg = nullptr; int K, N, ldw, koff = 0;
    if (r < I_IN) { W = F.in[3]; K = D; N = INW; WT = (bf16*)(ws + WS_WIN); ldw = K; kg = F.in[2]; }
    else if ((r -= I_IN) < I_AT) { W = F.in[13]; K = AW; N = D; WT = (bf16*)(ws + WS_WCAT); ldw = 2 * AW; }
    else if ((r -= I_AT) < I_RN) { W = F.in[14]; K = DR; N = D; WT = (bf16*)(ws + WS_WCAT); ldw = 2 * AW; koff = AW; }
    else if ((r -= I_RN) < I_OUT) { W = F.in[16]; K = D; N = D; WT = (bf16*)(ws + WS_WOUT); ldw = K; }
    else if ((r -= I_OUT) < I_UP) { W = F.in[18]; K = D; N = FF; WT = (bf16*)(ws + WS_WUP); ldw = K; kg = F.in[17]; }
    else { r -= I_UP; W = F.in[19]; K = FF; N = D; WT = (bf16*)(ws + WS_WDN); ldw = K; }
    const int nblk = N / 32, kb = r / nblk, nb = r % nblk;
    return TrItem{W, WT, kg, N, ldw, koff, 64 * kb, 32 * nb};
}
__device__ __forceinline__ void tr_items(Frame& F, LAS float* scr, int lo, int hi, int w, int nw) {
    if (lo + w < hi) {
        TrItem cur = tr_decode(F, lo + w); float wa[32], wb[32];
        tr_load(cur, F.lane, wa);
        for (int it = lo + w; it < hi; it += 2 * nw) {
            const bool h1 = it + nw < hi, h2 = it + 2 * nw < hi; TrItem nx = cur, n2 = cur;
            if (h1) { nx = tr_decode(F, it + nw); tr_load(nx, F.lane, wb); }
            tr_store(cur, F.lane, scr, wa);
            if (h2) { n2 = tr_decode(F, it + 2 * nw); tr_load(n2, F.lane, wa); }
            if (h1) tr_store(nx, F.lane, scr, wb);
            cur = n2;
        }
    }
}
__device__ __forceinline__ void p0_prologue(Frame& F) {
    LAS float* scr = (LAS float*)(F.lds + RING_OFF + F.wave * 16384);
    const int gw = F.vcu * NWAVES + F.wave, NGW = F.G * NWAVES;
    unsigned char* ws = F.ws;
    tr_items(F, scr, 0, I_IN + NITEMS_B, gw, NGW);
    for (int e = gw * 64 + F.lane; e < 2 * LRU_NB * NWAVES * 2 * 4 * 64; e += NGW * 64) {
        const int ln = e & 63, ks = (e >> 6) & 3, g = (e >> 8) & 1, wv = (e >> 9) & 7, n = (e >> 12) & 15, z = e >> 16;
        const float* wp = (g ? F.in[10] : F.in[8]) + (size_t)((z * LRU_NB + n) * LRU_BW + 32 * ks + 8 * (ln >> 4)) * LRU_BW + 16 * wv + (ln & 15);
        v4u o; o.x = pk2(wp[0 * LRU_BW], wp[1 * LRU_BW]); o.y = pk2(wp[2 * LRU_BW], wp[3 * LRU_BW]); o.z = pk2(wp[4 * LRU_BW], wp[5 * LRU_BW]); o.w = pk2(wp[6 * LRU_BW], wp[7 * LRU_BW]);
        *(GAS v4u*)(ws + WS_WF + (size_t)e * 16) = o; }
    if (gw < NTOK) {
        f32x4 va[16], vb[16]; row_load(xrow_ptr(F, gw), F.lane, va);
        for (int m = gw; m < NTOK; m += 2 * NGW) {
            const bool h1 = m + NGW < NTOK, h2 = m + 2 * NGW < NTOK;
            if (h1) row_load(xrow_ptr(F, m + NGW), F.lane, vb);
            x_store_bf16(va, (bf16*)(ws + WS_XBX), (float*)(F.ctl + CW_RS0), m, F.lane);
            if (h2) row_load(xrow_ptr(F, m + 2 * NGW), F.lane, va);
            if (h1) x_store_bf16(vb, (bf16*)(ws + WS_XBX), (float*)(F.ctl + CW_RS0), m + NGW, F.lane);
        }
    }
}
typedef unsigned short u16;
__device__ __forceinline__ float bf2f(unsigned short b) { return __uint_as_float((unsigned)b << 16); }
__device__ __forceinline__ float bflo(unsigned w) { return __uint_as_float(w << 16); }
__device__ __forceinline__ float bfhi(unsigned w) { return __uint_as_float(w & 0xffff0000u); }
__device__ __forceinline__ float sigm(float x) { return __builtin_amdgcn_rcpf(1.0f + __builtin_amdgcn_exp2f(-1.4426950408889634f * x)); }
__device__ __forceinline__ int seq_pos(int tok) { return tok < NTOK_P ? (tok & (SEQ_P - 1)) : tok - NTOK_P; }

#ifdef ATTN_NO_QROPE
constexpr int QKR_G = 5;
#else
constexpr int QKR_G = 1;
#endif
__device__ __forceinline__ void qk_norm_rope(Frame& F, bf16* Q, bf16* K) {
    const int gw = F.vcu * NWAVES + F.wave, NGW = F.G * NWAVES, lane = F.lane, c16 = lane & 15;
    float inv[4];
#pragma unroll
    for (int j = 0; j < 4; ++j) { const int pi = (4 * c16 + j) & 31; inv[j] = __builtin_amdgcn_exp2f(-(float)pi * (13.287712379549449f / 32.0f)); }
    float gq[8], gk[8];
#pragma unroll
    for (int e = 0; e < 8; ++e) { gq[e] = F.in[4][8 * c16 + e]; gk[e] = F.in[5][8 * c16 + e]; }
    constexpr int UB = 4;
    for (int it0 = gw; it0 < NTOK * QKR_G; it0 += NGW * UB) {
        v4u w[UB]; bf16* p[UB];
#pragma unroll
        for (int b = 0; b < UB; ++b) { const int it = it0 + b * NGW; const int tok = it / QKR_G, g = QKR_G == 1 ? 4 : it % QKR_G;
            p[b] = (g < 4 ? Q + (size_t)tok * AW + g * 512 : K + (size_t)tok * KVW) + (lane >> 4) * HD + 8 * c16;
            if (it < NTOK * QKR_G) w[b] = *(const GAS v4u*)p[b]; else w[b] = (v4u){0u, 0u, 0u, 0u}; }
#pragma unroll
        for (int b = 0; b < UB; ++b) { const int it = it0 + b * NGW; const int tok = it / QKR_G, g = QKR_G == 1 ? 4 : it % QKR_G;
            float x[8] = {bflo(w[b].x), bfhi(w[b].x), bflo(w[b].y), bfhi(w[b].y), bflo(w[b].z), bfhi(w[b].z), bflo(w[b].w), bfhi(w[b].w)};
            float s = 0.f;
#pragma unroll
            for (int e = 0; e < 8; ++e) s += x[e] * x[e];
            s += __shfl_xor(s, 1); s += __shfl_xor(s, 2); s += __shfl_xor(s, 4); s += __shfl_xor(s, 8);
            const float rs = 1.0f / sqrtf(s * (1.0f / HD) + NORM_EPS);
            const int pos = seq_pos(tok < NTOK ? tok : 0); const float pf = (float)(c16 < 8 ? (pos >> 6) : (pos & 63));
            float y[8];
#pragma unroll
            for (int j = 0; j < 4; ++j) { const float ang = pf * inv[j]; const float cs = cosf(ang), sn = sinf(ang);
                const float a = x[2 * j] * rs * (g < 4 ? gq[2 * j] : gk[2 * j]), bb = x[2 * j + 1] * rs * (g < 4 ? gq[2 * j + 1] : gk[2 * j + 1]);
                y[2 * j] = a * cs - bb * sn; y[2 * j + 1] = a * sn + bb * cs; }
            v4u o; o.x = pk2(y[0], y[1]); o.y = pk2(y[2], y[3]); o.z = pk2(y[4], y[5]); o.w = pk2(y[6], y[7]);
            if (it < NTOK * QKR_G) *(GAS v4u*)p[b] = o; }
    }
}

constexpr int LROW = 272;
constexpr int L_XC = 0, L_YT = 36864;
template <int DIR, bool FINAL>
__device__ __forceinline__ void lru_dir(LAS unsigned char* lds, const pg8::bf16x8* wf  , pg8::f32x4 (&hf)[8], float ba, float bi, float sp, float cin,
                                        int lane, int chl, float* aggP, float* aggH) {
    using pg8::f32x4; using pg8::bf16x8;
    const int fr = lane & 15, quad = lane >> 4;
    bf16x8 Bf[2][4];
#pragma unroll
    for (int g = 0; g < 2; ++g)
#pragma unroll
        for (int ks = 0; ks < 4; ++ks) Bf[g][ks] = wf[(g * 4 + ks) * 64 + lane];
    f32x4 accR[8], accI[8];
#pragma unroll
    for (int m = 0; m < 8; ++m) { accR[m] = (f32x4){0.f, 0.f, 0.f, 0.f}; accI[m] = (f32x4){0.f, 0.f, 0.f, 0.f}; }
    const int arow = 32 * (fr >> 2) + (fr & 3);
#pragma unroll
    for (int m = 0; m < 8; ++m)
#pragma unroll
        for (int ks = 0; ks < 4; ++ks) {
            const bf16x8 a = *(const LAS bf16x8*)(lds + L_XC + (arow + 4 * m) * LROW + (32 * ks + 8 * quad) * 2);
            accR[m] = __builtin_amdgcn_mfma_f32_16x16x32_bf16(a, Bf[0][ks], accR[m], 0, 0, 0);
            accI[m] = __builtin_amdgcn_mfma_f32_16x16x32_bf16(a, Bf[1][ks], accI[m], 0, 0, 0);
            if (ks == 3 && (m & 1)) __builtin_amdgcn_sched_barrier(0);
        }
    float cp = 1.f, hl = 0.f;
#pragma unroll
    for (int mm = 0; mm < 8; ++mm)
#pragma unroll
        for (int rr = 0; rr < 4; ++rr) {
            const int m = DIR ? 7 - mm : mm, r = DIR ? 3 - rr : rr;
            const int tau = 32 * quad + 4 * m + r;
            const float xv = bf2f(*(const LAS u16*)(lds + L_XC + tau * LROW + chl * 2));
            const float rg = sigm(accR[m][r] + ba), ig = sigm(accI[m][r] + bi);
            const float la = -8.0f * rg * sp;
            const float a = __builtin_amdgcn_exp2f(1.4426950408889634f * la);
            const float om = fmaf(-a, a, 1.0f);
            const float u = __builtin_amdgcn_sqrtf(om) * (ig * xv);
            cp = cp * a; hl = a * hl + u;
            accR[m][r] = cp; accI[m][r] = hl;
            if (rr == 3) __builtin_amdgcn_sched_barrier(0);
        }
    float Pq[4], Hq[4];
#pragma unroll
    for (int q = 0; q < 4; ++q) { Pq[q] = __shfl(cp, fr + 16 * q); Hq[q] = __shfl(hl, fr + 16 * q); }
    float cm;
    if (DIR == 0) { const float c1 = Pq[0] * cin + Hq[0], c2 = Pq[1] * c1 + Hq[1], c3 = Pq[2] * c2 + Hq[2], c4 = Pq[3] * c3 + Hq[3];
        cm = quad == 0 ? cin : quad == 1 ? c1 : quad == 2 ? c2 : c3; *aggH = c4; }
    else { const float d2 = Pq[3] * cin + Hq[3], d1 = Pq[2] * d2 + Hq[2], d0 = Pq[1] * d1 + Hq[1], de = Pq[0] * d0 + Hq[0];
        cm = quad == 3 ? cin : quad == 2 ? d2 : quad == 1 ? d1 : d0; *aggH = de; }
    *aggP = (Pq[0] * Pq[1]) * (Pq[2] * Pq[3]);
    if (FINAL) {
#pragma unroll
        for (int m = 0; m < 8; ++m) { const f32x4 h = accI[m] + accR[m] * cm; hf[m] = DIR == 0 ? h : hf[m] + h; }
    }
}
template <bool FINAL>
__device__ __forceinline__ void lru_phase(Frame& F, const bf16* XR, const bf16* YR, bf16* REC) {
    using pg8::f32x4; using pg8::bf16x8;
    LAS unsigned char* lds = F.lds + RING_OFF;
    const int w = F.wave;
    float* AGG = (float*)(F.ws + WS_AGG); const float* CARRY = (const float*)(F.ws + WS_CARRY);
    const bf16x8* WF = (const bf16x8*)(F.ws + WS_WF); float ba[2], bi[2], sp[2]; int cur_n = -1;
    for (int L = blockIdx.x; L < NCHUNK * LRU_NB; L += F.G) {
        const int chunk = L / LRU_NB, n = L % LRU_NB, t0 = chunk * LCH;
        int tid = F.tid; asm volatile("" : "+v"(tid));
        const int lane = tid & 63, fr = lane & 15, quad = lane >> 4, chl = 16 * w + fr;
        const int cg = tid & 15, tg = tid >> 4;
        if (n != cur_n) {
            cur_n = n;
#pragma unroll
            for (int z = 0; z < 2; ++z) { const int ch = z * DR + n * LRU_BW + chl; ba[z] = F.in[9][ch]; bi[z] = F.in[11][ch]; sp[z] = log1pf(expf(-F.in[12][ch])); }
        }
        __syncthreads();
        {
            const int ch0 = n * LRU_BW + 8 * cg; const int p0 = seq_pos(t0), slen = t0 < NTOK_P ? SEQ_P : SEQ_S;
            float cw[4][8], cb[8];
#pragma unroll
            for (int j = 0; j < 4; ++j)
#pragma unroll
                for (int e = 0; e < 8; ++e) cw[j][e] = F.in[6][j * DR + ch0 + e];
#pragma unroll
            for (int e = 0; e < 8; ++e) cb[e] = F.in[7][ch0 + e];
            v4u xin[7];
#pragma unroll
            for (int i = 0; i < 7; ++i) { const int lt = 4 * tg - 1 + i, p = p0 + lt;
                xin[i] = (p >= 0 && p < slen) ? *(const GAS v4u*)(XR + (size_t)(t0 + lt) * DR + ch0) : (v4u){0u, 0u, 0u, 0u}; }
#pragma unroll
            for (int k = 0; k < 4; ++k) { float o[8];
#pragma unroll
                for (int e = 0; e < 8; ++e) o[e] = cb[e];
#pragma unroll
                for (int j = 0; j < 4; ++j) { const v4u v = xin[k + j]; const float xv[8] = {bflo(v.x), bfhi(v.x), bflo(v.y), bfhi(v.y), bflo(v.z), bfhi(v.z), bflo(v.w), bfhi(v.w)};
#pragma unroll
                    for (int e = 0; e < 8; ++e) o[e] += cw[j][e] * xv[e]; }
                v4u pk; pk.x = pk2(o[0], o[1]); pk.y = pk2(o[2], o[3]); pk.z = pk2(o[4], o[5]); pk.w = pk2(o[6], o[7]);
                *(LAS v4u*)(lds + L_XC + (4 * tg + k) * LROW + cg * 16) = pk; }
            if (FINAL) {
#pragma unroll
                for (int k = 0; k < 4; ++k) *(LAS v4u*)(lds + L_YT + (4 * tg + k) * LROW + cg * 16) = *(const GAS v4u*)(YR + (size_t)(t0 + 4 * tg + k) * DR + ch0); }
        }
        float cinf = 0.f, cinb = 0.f;
        if (FINAL) { cinf = CARRY[((size_t)chunk * 2 + 0) * DR + n * LRU_BW + chl]; cinb = CARRY[((size_t)chunk * 2 + 1) * DR + n * LRU_BW + chl]; }
        __syncthreads();
        f32x4 hf[8]; float aP, aH;
        lru_dir<0, FINAL>(lds, WF + (size_t)((0 * LRU_NB + n) * NWAVES + w) * 512, hf, ba[0], bi[0], sp[0], cinf, lane, chl, &aP, &aH);
        if (!FINAL && quad == 0) { float* ag = AGG + (size_t)chunk * 4 * DR + n * LRU_BW + chl; ag[0] = aP; ag[DR] = aH; }
        lru_dir<1, FINAL>(lds, WF + (size_t)((1 * LRU_NB + n) * NWAVES + w) * 512, hf, ba[1], bi[1], sp[1], cinb, lane, chl, &aP, &aH);
        if (!FINAL && quad == 0) { float* ag = AGG + (size_t)chunk * 4 * DR + n * LRU_BW + chl; ag[2 * DR] = aP; ag[3 * DR] = aH; }
        if (FINAL) {
#pragma unroll
            for (int m = 0; m < 8; ++m)
#pragma unroll
                for (int r = 0; r < 4; ++r) { const int tau = 32 * quad + 4 * m + r; LAS u16* yp = (LAS u16*)(lds + L_YT + tau * LROW + chl * 2);
                    const float y = bf2f(*yp); const float ge = y * sigm(1.5957691216057308f * (y + 0.044715f * y * y * y));
                    *yp = (u16)f2bf(hf[m][r] * ge); if (r == 3) __builtin_amdgcn_sched_barrier(0); }
            __syncthreads();
#pragma unroll
            for (int k = 0; k < 4; ++k) *(GAS v4u*)(REC + pg8::toff(t0 + 4 * tg + k, DR + n * LRU_BW + 8 * cg, 2 * DR)) = *(const LAS v4u*)(lds + L_YT + (4 * tg + k) * LROW + cg * 16);
        }
    }
    __syncthreads();
}
__device__ __forceinline__ void lru_carry(Frame& F) {
    const float* AGG = (const float*)(F.ws + WS_AGG); float* CARRY = (float*)(F.ws + WS_CARRY);
    const int per = (5 * 2 * DR + F.G - 1) / F.G;
    if (F.tid < per) {
        const int id = F.vcu * per + F.tid;
        if (id < 5 * 2 * DR) {
            const int s = id / (2 * DR), dir = (id / DR) & 1, ch = id % DR;
            const int c0 = s < 4 ? 32 * s : 128, nc = s < 4 ? 32 : 64;
            float h = 0.f;
            for (int b = 0; b < nc; b += 16) {
                float P[16], H[16];
#pragma unroll
                for (int j = 0; j < 16; ++j) { const int c = dir == 0 ? c0 + b + j : c0 + nc - 1 - b - j; P[j] = AGG[((size_t)c * 4 + 2 * dir) * DR + ch]; H[j] = AGG[((size_t)c * 4 + 2 * dir + 1) * DR + ch]; }
#pragma unroll
                for (int j = 0; j < 16; ++j) { const int c = dir == 0 ? c0 + b + j : c0 + nc - 1 - b - j; CARRY[((size_t)c * 2 + dir) * DR + ch] = h; h = P[j] * h + H[j]; }
            }
        }
    }
}
__device__ __forceinline__ void attn_phase_all(Frame& F, char* lds, const bf16* Q, const bf16* K, const bf16* V, bf16* O) {
    for (int L = blockIdx.x; L < 1536; L += F.G) {
        const int c = L & 255, i = L >> 8, xcd = c & 7, rank = c >> 3;
        int row0, head, kvh, qb, seq;
        if (i < 2) { const int idx = i * 32 + rank, grp = xcd >> 1, u = (xcd & 1) * 64 + idx; kvh = grp; head = grp * 4 + (u >> 5); qb = u & 31; row0 = NTOK_P; seq = SEQ_S; }
        else { const int idx = (i - 2) * 32 + rank, grp = 2 * xcd + (idx >> 6), v = idx & 63, b = grp >> 2; kvh = grp & 3; head = kvh * 4 + (v >> 4); qb = v & 15; row0 = b * SEQ_P; seq = SEQ_P; }
        attn::attn_dense_body(Q + (size_t)(row0 + qb * 256) * AW + head * HD, K + (size_t)row0 * KVW + kvh * HD, V + (size_t)row0 * KVW + kvh * HD,
                              O, row0 + qb * 256, head * HD, seq, lds, F.in[4], qb * 256);
    }
}
#ifndef MK_DUP
#define MK_DUP -1
#endif
#ifndef MK_REP30
#define MK_REP30 1
#endif
#ifndef MK_NO_XB
#define MK_NO_XB 0
#endif
#ifndef ORD_1
#define ORD_1 pg8::StaticOrder
#endif
#ifndef ORD_5
#define ORD_5 pg8::SharedOrder
#endif
#ifndef ORD_6
#define ORD_6 pg8::SharedOrder
#endif
#ifndef ORD_UP
#define ORD_UP pg8::StaticOrder
#endif
#ifndef ORD_DN
#define ORD_DN pg8::StaticOrder
#endif
#ifndef DN_WGM_ARG
#define DN_WGM_ARG
#endif
#ifndef WGM_UP
#define WGM_UP 8
#endif
#ifndef WGM_DN
#define WGM_DN 8
#endif
#ifndef WGM_1
#define WGM_1 8
#endif
#ifndef X2_F32
#define X2_F32 false
#endif
#ifndef PG_ALIGN
#define PG_ALIGN true
#endif
#ifndef PG_SP2
#define PG_SP2 true
#endif
constexpr int NPH = 8 + 2 * MLP_CHUNKS;
struct Args { const float* in[21]; float* out; unsigned char* ws; int ph_lo, ph_hi; };
__global__ void __launch_bounds__(NWAVES * 64, 2) mk_fwd(Args args) {
    extern __shared__ __attribute__((aligned(16))) unsigned char lds[];
    Frame F;
    F.lds = (LAS unsigned char*)lds;
    F.MISC = (volatile LAS unsigned*)(F.lds + MISC_OFF);
    F.tid = threadIdx.x; F.lane = F.tid & 63; F.wave = __builtin_amdgcn_readfirstlane(F.tid >> 6);
    F.G = gridDim.x; { const int bx = blockIdx.x; F.vcu = (F.G % 8 == 0) ? (bx % 8) * (F.G / 8) + bx / 8 : bx; }
    unsigned char* ws = args.ws; F.ws = ws; F.out = args.out;
#pragma unroll
    for (int i = 0; i < 21; ++i) F.in[i] = args.in[i];
    F.ctl = (gu32*)(ws + WS_CTL);
    for (int u = F.tid; u < (LDS_BYTES - LDSCTL_OFF) / 4; u += NWAVES * 64) ((LAS unsigned*)(F.lds + LDSCTL_OFF))[u] = 0u;
    __syncthreads();
    XcdBarrier bar; bar.bar = (unsigned*)(F.ctl + CW_BAR); bar.x = 0; bar.st = nullptr;
    if (!MK_PER_PHASE) bar = xcd_barrier_post((unsigned*)(F.ctl + CW_BAR), F.MISC + 8);
    const int lo = args.ph_lo, hi = args.ph_hi;
#define IN(k) (lo <= (k) && (k) < hi)
#define SEAM(k) do { if (IN(k) && IN((k) + 1)) xcd_barrier(bar); } while (0)
    const int gw = F.vcu * NWAVES + F.wave, NGW = F.G * NWAVES;
    bf16* const W_IN = (bf16*)(ws + WS_WIN); bf16* const W_CAT = (bf16*)(ws + WS_WCAT); bf16* const W_OUT = (bf16*)(ws + WS_WOUT);
    bf16* const W_UP = (bf16*)(ws + WS_WUP); bf16* const W_DN = (bf16*)(ws + WS_WDN);
    bf16* const H1 = (bf16*)(ws + WS_XBX)  ; bf16* const AR = (bf16*)(ws + WS_AR); bf16* const HM = (bf16*)(ws + WS_HM);
    bf16* const QB = (bf16*)(ws + WS_Q); bf16* const KB = (bf16*)(ws + WS_K); bf16* const VB = (bf16*)(ws + WS_V); bf16* const XR = (bf16*)(ws + WS_XR); bf16* const YR = (bf16*)(ws + WS_YR);
    bf16* const MRG = (bf16*)(ws + WS_MRG); bf16* const HID = (bf16*)(ws + WS_HID);
    float* const RSQ1 = (float*)(F.ctl + CW_RSQ1); float* const RSQ2 = (float*)(F.ctl + CW_RSQ2);
    unsigned char* const G0 = (unsigned char*)F.out; unsigned char* const G1 = G0 + (size_t)NTOK * D;

    if (IN(0)) _Pragma("unroll") for (int rep_ = 0; rep_ < (MK_DUP == 0 ? 2 : 1); ++rep_) { p0_prologue(F); }
    SEAM(0);
#if MK_STAGE >= 9
#ifdef MK_PROBE_PH1NULL
    if (IN(1)) { pg8::Gemm g{H1, W_IN, NTOK, INW, D}; ORD_1 S; S.init(NTOK, INW, F.G, (int)blockIdx.x);
        pg8::EpiNull E{MRG}; pg8::gemm_phase<pg8::EpiNull, ORD_1, PG_ALIGN, PG_SP2>(F.lds + RING_OFF, g, S, E); }
#endif
#ifdef MK_STAG1
    if (IN(1) && (int)blockIdx.x >= 128) { const unsigned long long t0 = __builtin_amdgcn_s_memrealtime();
        while (__builtin_amdgcn_s_memrealtime() - t0 < (unsigned long long)MK_STAG1) __builtin_amdgcn_s_sleep(8); }
#endif
    if (IN(1)) _Pragma("unroll") for (int rep_ = 0; rep_ < (MK_DUP == 1 ? 2 : 1); ++rep_) {
        pg8::Gemm g{H1, W_IN, NTOK, INW, D}; ORD_1 S; S.init(NTOK, INW, F.G, (int)blockIdx.x);
        pg8::EpiZ E{QB, KB, VB, XR, YR, G0, G1, F.in[15], (const float*)(F.ctl + CW_RS0)};
        pg8::gemm_phase<pg8::EpiZ, ORD_1, PG_ALIGN, PG_SP2>(F.lds + RING_OFF, g, S, E);
    }
    SEAM(1);
    if (IN(2)) {
#ifndef NO_ROPE
        qk_norm_rope(F, QB, KB);
#endif
#ifndef NO_LRU1
        lru_phase<false>(F, XR, YR, nullptr);
        if (MK_DUP == 20) lru_phase<false>(F, XR, YR, nullptr);
#endif
    }
    SEAM(2);
    if (IN(3)) { lru_carry(F);
#ifndef NO_ATTN
        for (int rep_ = 0; rep_ < MK_REP30; ++rep_) attn_phase_all(F, (char*)lds + RING_OFF, QB, KB, VB, AR);
#endif
    }
    SEAM(3);
    if (IN(4)) {
#ifndef NO_LRU3
        lru_phase<true>(F, XR, YR, AR);
        if (MK_DUP == 40) lru_phase<true>(F, XR, YR, AR);
#endif
    }
    SEAM(4);
    if (IN(5)) _Pragma("unroll") for (int rep_ = 0; rep_ < (MK_DUP == 5 ? 2 : 1); ++rep_) {
        pg8::Gemm g{AR, W_CAT, NTOK, D, 2 * AW}; ORD_5 S; S.init(NTOK, D, F.G, (int)blockIdx.x);
        pg8::EpiMerge E{MRG, G0, G1, D};
        pg8::gemm_phase<pg8::EpiMerge, ORD_5, PG_ALIGN, PG_SP2>(F.lds + RING_OFF, g, S, E);
    }
    SEAM(5);
#ifdef MK_STAGGER6
    if (IN(6)) { const unsigned long long t0 = __builtin_amdgcn_s_memrealtime(), dl = (unsigned long long)(blockIdx.x / 8 % 4) * MK_STAGGER6;
        while (__builtin_amdgcn_s_memrealtime() - t0 < dl) __builtin_amdgcn_s_sleep(8); }
#endif
    if (IN(6)) _Pragma("unroll") for (int rep_ = 0; rep_ < (MK_DUP == 6 ? 2 : 1); ++rep_) {
        pg8::Gemm g{MRG, W_OUT, NTOK, D, D}; ORD_6 S; S.init(NTOK, D, F.G, (int)blockIdx.x);
        typedef pg8::EpiResP<false> EpiX1; EpiX1 E{D, H1, HM, rep_ ? (float*)(F.ws + WS_AGG) : RSQ1, nullptr, 0.f, 0.f};
        pg8::gemm_phase<EpiX1, ORD_6, PG_ALIGN, PG_SP2>(F.lds + RING_OFF, g, S, E);
    }
    SEAM(6);
#ifdef MK_XBAR
    if (IN(6) && IN(7)) { for (int k_ = 0; k_ < MK_XBAR; ++k_) xcd_barrier(bar); }
#endif
#endif
#define MLP_UP(c) do { pg8::Gemm g{HM + (size_t)(c) * MLP_ROWS * D, W_UP, MLP_ROWS, FF, D}; ORD_UP S; S.init(MLP_ROWS, FF, F.G, (int)blockIdx.x); \
        pg8::EpiRelu2 E{HID, FF}; pg8::gemm_phase<pg8::EpiRelu2, ORD_UP, PG_ALIGN, PG_SP2>(F.lds + RING_OFF, g, S, E); } while (0)
#define MLP_DN(c) do { pg8::Gemm g{HID, W_DN, MLP_ROWS, D, FF}; ORD_DN S; S.init(MLP_ROWS, D, F.G, (int)blockIdx.x DN_WGM_ARG); float* o = F.out + (size_t)(c) * MLP_ROWS * D; \
        typedef pg8::EpiResP<true> EpiDn; EpiDn E{D, HM + (size_t)(c) * MLP_ROWS * D, HM + (size_t)(c) * MLP_ROWS * D, RSQ2 + (c) * MLP_ROWS, RSQ1 + (c) * MLP_ROWS, 1.0f / D, NORM_EPS}; pg8::gemm_phase<EpiDn, ORD_DN, PG_ALIGN, PG_SP2>(F.lds + RING_OFF, g, S, E); } while (0)
#ifdef MK_PROBE_UPNULL
    if (IN(7)) { pg8::Gemm g{HM, W_UP, MLP_ROWS, FF, D}; ORD_UP S; S.init(MLP_ROWS, FF, F.G, (int)blockIdx.x);
        pg8::EpiNull E{MRG}; pg8::gemm_phase<pg8::EpiNull, ORD_UP, PG_ALIGN, PG_SP2>(F.lds + RING_OFF, g, S, E); }
#endif
#ifdef MK_PROBE_L2
#ifndef MK_PROBE_K
#define MK_PROBE_K 1024
#endif
    if (IN(7)) { pg8::Gemm g{HM, W_UP, 512, 512, MK_PROBE_K}; pg8::RepOrder S{MK_PROBE_L2, (int)(blockIdx.x & 1), (int)((blockIdx.x >> 1) & 1)};
#ifdef MK_PROBE_RELU
        pg8::EpiRelu2 E{W_IN, FF}; pg8::gemm_phase<pg8::EpiRelu2, pg8::RepOrder, true, true>(F.lds + RING_OFF, g, S, E); }
#else
        pg8::EpiNull E{MRG}; pg8::gemm_phase<pg8::EpiNull, pg8::RepOrder, true, true>(F.lds + RING_OFF, g, S, E); }
#endif
#endif
    if (IN(7)) _Pragma("unroll") for (int rep_ = 0; rep_ < (MK_DUP == 8 ? 2 : 1); ++rep_) MLP_UP(0);
    SEAM(7);
    if (IN(8)) MLP_DN(0);
    if (IN(8) && MK_DUP == 90) { pg8::Gemm g{HID, W_DN, MLP_ROWS, D, FF}; ORD_DN S; S.init(MLP_ROWS, D, F.G, (int)blockIdx.x); float* o = F.out;
        typedef pg8::EpiResF32<true, true, false, true> EpiDn; EpiDn E{nullptr, nullptr, 0, o, D, nullptr, (float*)(F.ws + WS_AGG), RSQ1, 1.0f / D, NORM_EPS, HM}; pg8::gemm_phase<EpiDn, ORD_DN, PG_ALIGN, PG_SP2>(F.lds + RING_OFF, g, S, E); }
    SEAM(8);
    if (IN(9)) MLP_UP(1);
    SEAM(9);
    if (IN(10)) MLP_DN(1);
    SEAM(10);
#if MLP_NCH == 3
    if (IN(11)) MLP_UP(2);
    SEAM(11);
    if (IN(12)) MLP_DN(2);
    SEAM(12);
#endif
    if (IN(NPH - 1) && X2_F32 && gw < NTOK) {
        f32x4 va[16], vb[16]; row_load(F.out + (size_t)gw * D, F.lane, va);
        for (int m = gw; m < NTOK; m += 2 * NGW) {
            const bool h1 = m + NGW < NTOK, h2 = m + 2 * NGW < NTOK;
            if (h1) row_load(F.out + (size_t)(m + NGW) * D, F.lane, vb);
            scale_store_f32(va, F.in[20], RSQ2[m], F.out + (size_t)m * D, F.lane);
            if (h2) row_load(F.out + (size_t)(m + 2 * NGW) * D, F.lane, va);
            if (h1) scale_store_f32(vb, F.in[20], RSQ2[m + NGW], F.out + (size_t)(m + NGW) * D, F.lane);
        }
    }
    if (IN(NPH - 1) && !X2_F32) {
        const int c8 = F.lane & 7, r8 = F.lane >> 3;
        for (int it = gw; it < (NTOK / 256) * (D / 64); it += NGW) {
            const int rt = it / (D / 64), kt = it % (D / 64), col = kt * 64 + 8 * c8;
            const f32x4 g0 = *(const GAS f32x4*)(F.in[20] + col), g1 = *(const GAS f32x4*)(F.in[20] + col + 4);
            const GAS v4u* src = (const GAS v4u*)(HM + (size_t)it * 16384) + F.lane;
#pragma unroll 1
            for (int i0 = 0; i0 < 32; i0 += 8) {
                v4u w[8]; float ss[8];
#pragma unroll
                for (int i = 0; i < 8; ++i) { w[i] = src[(i0 + i) * 64]; ss[i] = RSQ2[rt * 256 + 8 * (i0 + i) + r8]; }
#pragma unroll
                for (int i = 0; i < 8; ++i) { const float rs = 1.0f / sqrtf(ss[i] * (1.f / D) + NORM_EPS);
                    f32x4 a = {bflo(w[i].x), bfhi(w[i].x), bflo(w[i].y), bfhi(w[i].y)}, b = {bflo(w[i].z), bfhi(w[i].z), bflo(w[i].w), bfhi(w[i].w)};
                    GAS f32x4* dst = (GAS f32x4*)(F.out + (size_t)(rt * 256 + 8 * (i0 + i) + r8) * D + col);
                    dst[0] = a * rs * g0; dst[1] = b * rs * g1; }
            }
        }
    }
#undef IN
#undef SEAM
}

extern "C" void kernel_launch(void* const* d_in, const int* in_sizes, int n_in, void* d_out, int out_size, void* d_ws, size_t ws_size, hipStream_t stream) {
    static int grid = 0;
    if (grid == 0) {
        if (n_in != 21 || in_sizes[0] != NTOK_P * D || in_sizes[1] != NTOK_S * D || out_size != NTOK * D || ws_size < WS_END) {
            fprintf(stderr, "kernel_launch: shape / workspace mismatch (n_in %d, out %d, ws %zu, need %zu); nothing launched\n", n_in, out_size, ws_size, (size_t)WS_END); grid = -1; return; }
        int dev = 0, cus = 0, per_cu = 0;
        if (hipGetDevice(&dev) != hipSuccess || hipDeviceGetAttribute(&cus, hipDeviceAttributeMultiprocessorCount, dev) != hipSuccess) { grid = -1; return; }
        if (hipFuncSetAttribute((const void*)mk_fwd, hipFuncAttributeMaxDynamicSharedMemorySize, LDS_BYTES) != hipSuccess) { fprintf(stderr, "kernel_launch: hipFuncSetAttribute failed\n"); grid = -1; return; }
        if (hipOccupancyMaxActiveBlocksPerMultiprocessor(&per_cu, (const void*)mk_fwd, NWAVES * 64, LDS_BYTES) != hipSuccess || per_cu < 1) { fprintf(stderr, "kernel_launch: occupancy query says %d blocks per CU\n", per_cu); grid = -1; return; }
        (void)hipGetLastError();
        grid = cus;
    }
    if (grid < 0) return;
    if (hipMemsetAsync((char*)d_ws + WS_CTL, 0, CTL_ZERO_BYTES, stream) != hipSuccess) return;
    Args a{};
    for (int i = 0; i < 21; ++i) a.in[i] = (const float*)d_in[i];
    a.out = (float*)d_out; a.ws = (unsigned char*)d_ws;
#if MK_PER_PHASE
    for (int p = 0; p < NPH; ++p) { a.ph_lo = p; a.ph_hi = p + 1; hipLaunchKernelGGL(mk_fwd, dim3(grid), dim3(NWAVES * 64), LDS_BYTES, stream, a); }
#else
    a.ph_lo = 0; a.ph_hi = NPH; hipLaunchKernelGGL(mk_fwd, dim3(grid), dim3(NWAVES * 64), LDS_BYTES, stream, a);
#endif
    const hipError_t le = hipPeekAtLastError();
    if (le != hipSuccess) fprintf(stderr, "kernel_launch: launch failed: %s\n", hipGetErrorName(le));
}
```
